# Optimizing an MI355X kernel written in HIP

```python
import math
import jax, jax.numpy as jnp
from jax import lax
import numpy as np

D_MODEL = 1024
BATCH = 2
SEQ = 8192
DEPTH = 1
DEC_BATCH = 4
DEC_SEQ = 4096
PAST_LEN = 128

EPS = 1e-6
HEAD_DIM = 64
ATTN_GROUPS = ((128, 1), (512, 4), (2048, 16))
N_GROUPS = 3
HEADS_PER_GROUP = D_MODEL // 128
N_ATTN_HEADS = N_GROUPS * HEADS_PER_GROUP
ATTN_QKV_WIDTH = N_ATTN_HEADS * HEAD_DIM
ATTN_WIDTH = HEADS_PER_GROUP * HEAD_DIM
HYENA_WIDTH = D_MODEL
HYENA_ORDER = 2
SHORT_CONV = 3
FILTER_EMB = 33
N_BANDS = (FILTER_EMB - 1) // 2
FILTER_HIDDEN = 64
DECAY_TARGET = 1e-2
FAST_DECAY_PCT = 0.3
SLOW_DECAY_PCT = 1.5
NUM_BUCKETS = 32
MAX_DISTANCE = 1024
NEG_INF = -1e30
IN_SIZES = (ATTN_QKV_WIDTH, ATTN_QKV_WIDTH, ATTN_QKV_WIDTH, ATTN_WIDTH, 3 * HYENA_WIDTH, HYENA_WIDTH, 2 * D_MODEL)
IN_WIDTH = 3 * ATTN_QKV_WIDTH + ATTN_WIDTH + 4 * HYENA_WIDTH + 2 * D_MODEL

kernel_name = 'hybrid_dilated_attn_hyena_encoder'


def _split_points():
    return [int(c) for c in np.cumsum(IN_SIZES)[:-1]]


def _rms_norm(x, g):
    xf = x.astype(jnp.float32)
    y = xf * lax.rsqrt(jnp.mean(xf * xf, axis=-1, keepdims=True) + EPS)
    return (y * g.astype(jnp.float32)).astype(x.dtype)


def _t5_bucket(rel):
    half = NUM_BUCKETS // 2
    max_exact = half // 2
    n = jnp.abs(rel)
    nf = jnp.maximum(n, 1).astype(jnp.float32)
    large = max_exact + (jnp.log(nf / max_exact) / math.log(MAX_DISTANCE / max_exact) * (half - max_exact)).astype(jnp.int32)
    large = jnp.minimum(large, half - 1)
    return jnp.where(rel > 0, half, 0) + jnp.where(n < max_exact, n, large)


def _dilated_window_attention(q, k, v, bias_table, window, dilation):
    b, s, h, hd = q.shape
    r = dilation
    blk = window // (2 * dilation)
    lr = s // r
    nb = -(-lr // blk)
    lp = nb * blk

    def to_sub(t):
        t = t.reshape(b, lr, r, h, hd).transpose(0, 2, 1, 3, 4)
        return jnp.pad(t, ((0, 0), (0, 0), (0, lp - lr), (0, 0), (0, 0)))

    def neighbours(t):
        t = jnp.pad(t, ((0, 0), (0, 0), (blk, blk), (0, 0), (0, 0))).reshape(b, r, nb + 2, blk, h, hd)
        return jnp.concatenate([t[:, :, :-2], t[:, :, 1:-1], t[:, :, 2:]], axis=3)

    qb = to_sub(q).reshape(b, r, nb, blk, h, hd).astype(jnp.float32)
    kb = neighbours(to_sub(k)).astype(jnp.float32)
    vb = neighbours(to_sub(v)).astype(jnp.float32)
    qi = jnp.arange(blk)[:, None]
    kj = jnp.arange(3 * blk)[None, :] - blk
    delta = kj - qi
    bias = bias_table.astype(jnp.float32)[_t5_bucket(delta * r)].transpose(2, 0, 1)
    key_sub = jnp.arange(nb)[:, None, None] * blk + kj[None]
    valid = (jnp.abs(delta) <= blk)[None] & (key_sub >= 0) & (key_sub < lr)
    logits = jnp.einsum('brnqhd,brnkhd->brnhqk', qb, kb) * (hd ** -0.5) + bias
    logits = jnp.where(valid[:, None], logits, NEG_INF)
    m = jnp.max(logits, axis=-1, keepdims=True)
    p = jnp.exp(logits - m)
    den = jnp.sum(p, axis=-1)
    o = jnp.einsum('brnhqk,brnkhd->brnqhd', p, vb) / jnp.swapaxes(den, -1, -2)[..., None]
    lse = m[..., 0] + jnp.log(den)
    o = o.reshape(b, r, lp, h, hd)[:, :, :lr].transpose(0, 2, 1, 3, 4).reshape(b, s, h, hd)
    lse = jnp.swapaxes(lse, -1, -2).reshape(b, r, lp, h)[:, :, :lr].transpose(0, 2, 1, 3).reshape(b, s, h)
    return o, lse


def _hyena_filters(length, w1, b1, w2, b2, w3, b3, w4, freq):
    f32 = jnp.float32
    t = jnp.linspace(0.0, 1.0, length, dtype=f32)[:, None]
    ang = (2.0 * math.pi / length) * jnp.arange(length, dtype=f32)[:, None]
    bands = jnp.linspace(1e-4, N_BANDS - 1, N_BANDS, dtype=f32)[None]
    z = jnp.concatenate([t, jnp.cos(ang * bands), -jnp.sin(ang * bands)], axis=-1)
    fr = freq.astype(f32)
    hdn = jnp.sin(fr * (z @ w1.astype(f32) + b1.astype(f32)))
    hdn = jnp.sin(fr * (hdn @ w2.astype(f32) + b2.astype(f32)))
    hdn = jnp.sin(fr * (hdn @ w3.astype(f32) + b3.astype(f32)))
    filt = hdn @ w4.astype(f32)
    max_decay = math.log(DECAY_TARGET) / FAST_DECAY_PCT
    min_decay = math.log(DECAY_TARGET) / SLOW_DECAY_PCT
    deltas = jnp.abs(jnp.linspace(min_decay, max_decay, HYENA_WIDTH, dtype=f32))
    decay = jnp.exp(-t * deltas[None])
    return filt.reshape(length, HYENA_ORDER, 2, HYENA_WIDTH) * decay[:, None, None]


def _long_conv(z, h_fwd, h_bwd, skip):
    length = z.shape[1]
    c = z.shape[-1]
    kcirc = jnp.concatenate([h_fwd, jnp.zeros((1, c), jnp.float32), h_bwd[:0:-1]], axis=0)
    zf = z.astype(jnp.float32)
    spec = jnp.fft.rfft(zf, n=2 * length, axis=1) * jnp.fft.rfft(kcirc, axis=0)[None]
    y = jnp.fft.irfft(spec, n=2 * length, axis=1)[:, :length]
    return y + zf * skip.astype(jnp.float32)


def _layer(x, rel_bias, pre_g, post_g, w_in, conv_w, conv_b, fw1, fb1, fw2, fb2, fw3, fb3, fw4, ffreq, skip, w_br_a, w_br_h, w_out):
    b, s, _ = x.shape
    f32 = jnp.float32
    hn = _rms_norm(x, pre_g)
    proj = jnp.einsum('bsd,de->bse', hn, w_in)
    q, k, v, gate_a, u_hy, gate_h, merge = jnp.split(proj, _split_points(), axis=-1)
    q = q.reshape(b, s, N_GROUPS, HEADS_PER_GROUP, HEAD_DIM)
    k = k.reshape(b, s, N_GROUPS, HEADS_PER_GROUP, HEAD_DIM)
    v = v.reshape(b, s, N_GROUPS, HEADS_PER_GROUP, HEAD_DIM)

    outs, lses = [], []
    for g, (window, dilation) in enumerate(ATTN_GROUPS):
        o_g, lse_g = _dilated_window_attention(q[:, :, g], k[:, :, g], v[:, :, g], rel_bias[:, g * HEADS_PER_GROUP:(g + 1) * HEADS_PER_GROUP], window, dilation)
        outs.append(o_g)
        lses.append(lse_g)
    wts = jax.nn.softmax(jnp.stack(lses), axis=0)
    attn = jnp.einsum('gbsh,gbshd->bshd', wts, jnp.stack(outs)).reshape(b, s, ATTN_WIDTH).astype(x.dtype)
    attn_branch = jnp.einsum('bse,ed->bsd', attn * jax.nn.silu(gate_a), w_br_a)

    up = jnp.pad(u_hy, ((0, 0), (1, 1), (0, 0)))
    u_c = up[:, :-2] * conv_w[0] + up[:, 1:-1] * conv_w[1] + up[:, 2:] * conv_w[2] + conv_b
    hv, hx1, hx2 = jnp.split(u_c, 3, axis=-1)
    filt = _hyena_filters(s, fw1, fb1, fw2, fb2, fw3, fb3, fw4, ffreq)
    zz = hx1.astype(f32) * _long_conv(hv, filt[:, 0, 0], filt[:, 0, 1], skip[0])
    zz = hx2.astype(f32) * _long_conv(zz, filt[:, 1, 0], filt[:, 1, 1], skip[1])
    hy = zz.astype(x.dtype)
    hy_branch = jnp.einsum('bse,ed->bsd', hy * jax.nn.silu(gate_h), w_br_h)

    g_a, g_h = jnp.split(merge, 2, axis=-1)
    merged = jax.nn.sigmoid(g_a) * attn_branch + jax.nn.sigmoid(g_h) * hy_branch
    out = jnp.einsum('bsd,de->bse', merged, w_out)
    return x + _rms_norm(out, post_g)


def setup_inputs(seed: int = 0) -> dict:
    key = jax.random.key(seed)
    ks = jax.random.split(key, 20)

    def nrm(k, shape, scale):
        return scale * jax.random.normal(k, shape, jnp.float32)

    D, L = D_MODEL, DEPTH
    return {
        'x_prompt': nrm(ks[0], (BATCH, SEQ, D), 1.0),
        'x_sample': nrm(ks[1], (DEC_BATCH, DEC_SEQ, D), 1.0),
        'rel_bias': nrm(ks[2], (NUM_BUCKETS, N_ATTN_HEADS), 0.2),
        'pre_norm_g': 1.0 + nrm(ks[3], (L, D), 0.1),
        'post_norm_g': 1.0 + nrm(ks[4], (L, D), 0.1),
        'w_in': nrm(ks[5], (L, D, IN_WIDTH), D ** -0.5),
        'conv_w': nrm(ks[6], (L, SHORT_CONV, 3 * HYENA_WIDTH), SHORT_CONV ** -0.5),
        'conv_b': nrm(ks[7], (L, 3 * HYENA_WIDTH), 0.02),
        'filt_w1': nrm(ks[8], (L, FILTER_EMB, FILTER_HIDDEN), FILTER_EMB ** -0.5),
        'filt_b1': nrm(ks[9], (L, FILTER_HIDDEN), 0.1),
        'filt_w2': nrm(ks[10], (L, FILTER_HIDDEN, FILTER_HIDDEN), FILTER_HIDDEN ** -0.5),
        'filt_b2': nrm(ks[11], (L, FILTER_HIDDEN), 0.1),
        'filt_w3': nrm(ks[12], (L, FILTER_HIDDEN, FILTER_HIDDEN), FILTER_HIDDEN ** -0.5),
        'filt_b3': nrm(ks[13], (L, FILTER_HIDDEN), 0.1),
        'filt_w4': nrm(ks[14], (L, FILTER_HIDDEN, HYENA_ORDER * 2 * HYENA_WIDTH), 0.05 * FILTER_HIDDEN ** -0.5),
        'filt_freq': 1.0 + nrm(ks[15], (L, FILTER_HIDDEN), 0.1),
        'hyena_skip': nrm(ks[16], (L, HYENA_ORDER, HYENA_WIDTH), 1.0),
        'w_branch_a': nrm(ks[17], (L, ATTN_WIDTH, D), ATTN_WIDTH ** -0.5),
        'w_branch_h': nrm(ks[18], (L, HYENA_WIDTH, D), HYENA_WIDTH ** -0.5),
        'w_out': nrm(ks[19], (L, D, D), D ** -0.5),
    }


def reference(x_prompt, x_sample, rel_bias, pre_norm_g, post_norm_g, w_in, conv_w, conv_b, filt_w1, filt_b1, filt_w2, filt_b2, filt_w3, filt_b3, filt_w4, filt_freq, hyena_skip, w_branch_a, w_branch_h, w_out):
    def run(x):
        for l in range(DEPTH):
            x = _layer(x, rel_bias, pre_norm_g[l], post_norm_g[l], w_in[l], conv_w[l], conv_b[l], filt_w1[l], filt_b1[l], filt_w2[l], filt_b2[l], filt_w3[l], filt_b3[l], filt_w4[l], filt_freq[l], hyena_skip[l], w_branch_a[l], w_branch_h[l], w_out[l])
        return x

    y_prompt = run(x_prompt)
    y_sample = run(x_sample)
    return (y_prompt, y_sample)
```

```cpp
#include <hip/hip_runtime.h>
#include <hip/hip_cooperative_groups.h>
#include <cstdio>
#include <cstdint>
namespace cg = cooperative_groups;

#define GAS __attribute__((address_space(1)))
#define LAS __attribute__((address_space(3)))
typedef unsigned short bf16;
typedef short bf16x8 __attribute__((ext_vector_type(8)));
typedef short s16x4 __attribute__((ext_vector_type(4)));
typedef float f32x4 __attribute__((ext_vector_type(4)));
typedef unsigned u32x4 __attribute__((ext_vector_type(4)));
typedef unsigned u32x2 __attribute__((ext_vector_type(2)));

constexpr int NWAVES = 8, NTHREADS = 512;
constexpr int LDS_BYTES = 147456;
constexpr int RING_BYTES = 131072;
constexpr int MISC_OFF = RING_BYTES + 320;
constexpr int HY_W4_OFF = RING_BYTES + 2048;
constexpr int DM = 1024, MTOK = 32768, HTOK = 16384;
constexpr float EPS = 1e-6f;
constexpr size_t MiB = (size_t)1 << 20;
constexpr size_t WS_CTL = 0, WS_WT = 1 * MiB, WS_WBA = 23 * MiB, WS_WBH = 24 * MiB, WS_WO = 26 * MiB, WS_HDN = 28 * MiB, WS_BT = 31 * MiB, WS_XN = 32 * MiB, WS_R = 96 * MiB;
constexpr size_t R_QK = 0, R_VT = 96 * MiB, R_GA = 144 * MiB;
constexpr size_t R_U = 0, R_HS = 96 * MiB, R_XS = 128 * MiB;
constexpr size_t R_MGS = 0, R_MRG = 64 * MiB, R_OUT = 96 * MiB;
constexpr size_t O_AS = 0, O_HST = 16 * MiB, O_ZZ = 48 * MiB;

__device__ __forceinline__ unsigned f2bf(float f) { unsigned u = __builtin_bit_cast(unsigned, f); return (u + 0x7fffu + ((u >> 16) & 1u)) >> 16; }
__device__ __forceinline__ unsigned pk2(float lo, float hi) { return f2bf(lo) | (f2bf(hi) << 16); }
__device__ __forceinline__ float bf2f(unsigned h) { return __builtin_bit_cast(float, h << 16); }
__device__ __forceinline__ float bflo(unsigned w) { return __builtin_bit_cast(float, w << 16); }
__device__ __forceinline__ float bfhi(unsigned w) { return __builtin_bit_cast(float, w & 0xffff0000u); }
__device__ __forceinline__ float sigmoidf_(float x) { return __builtin_amdgcn_rcpf(1.0f + __expf(-x)); }
__device__ __forceinline__ float wave_sum(float v) {
#pragma unroll
    for (int o = 1; o < 64; o <<= 1) v += __shfl_xor(v, o);
    return v;
}
#define LDS_WAIT() asm volatile("s_waitcnt lgkmcnt(0)" ::: "memory")

#define XB_TMO      128
#define XB_XCNT(j)  (256  + 64 * (j))
#define XB_XSUB(j)  (1280 + 64 * (j))
#define XB_XGEN(j)  (2304 + 64 * (j))
#define XB_TOP      3328
#define XB_TOPGEN   3392
#define XCD_BAR_WORDS 3456
#define XB_SPIN_CAP (1u << 18)
__device__ __forceinline__ unsigned xb_ld(unsigned* p)              { return __hip_atomic_load(p, __ATOMIC_RELAXED, __HIP_MEMORY_SCOPE_AGENT); }
__device__ __forceinline__ unsigned xb_add(unsigned* p, unsigned v) { return __hip_atomic_fetch_add(p, v, __ATOMIC_RELAXED, __HIP_MEMORY_SCOPE_AGENT); }
__device__ __forceinline__ unsigned xb_xcc_id() { return (unsigned)__builtin_amdgcn_s_getreg((3 << 11) | 20) & 0xFu; }
#define XB_SPIN(cond, bar) do { unsigned _sp = 0; while (cond) { __builtin_amdgcn_s_sleep(1); \
    if ((++_sp & 255u) == 0u) { if (xb_ld(&(bar)[XB_TMO])) break; if (_sp > XB_SPIN_CAP) { atomicAdd(&(bar)[XB_TMO], 1u); break; } } } } while (0)
struct XcdBarrier { unsigned* bar; unsigned x; volatile LAS unsigned* st; };
__device__ __forceinline__ XcdBarrier xcd_barrier_post(unsigned* bar, volatile LAS unsigned* st) {
    XcdBarrier b; b.bar = bar; b.x = xb_xcc_id(); b.st = st;
    if (threadIdx.x == 0) (void)xb_add(&bar[XB_XCNT(b.x)], 1u);
    return b;
}
__device__ __forceinline__ void xcd_barrier_complete(unsigned* bar, unsigned x, unsigned& nloc, unsigned& nx) {
    const unsigned G = gridDim.x * gridDim.y * gridDim.z;
    unsigned sum, cnt, mine, sp = 0u;
    for (;;) {
        sum = 0u; cnt = 0u; mine = 0u;
#pragma unroll
        for (unsigned j = 0; j < 16; ++j) { const unsigned c = xb_ld(&bar[XB_XCNT(j)]); sum += c; cnt += (c > 0u) ? 1u : 0u; mine = (j == x) ? c : mine; }
        if (sum == G) break;
        __builtin_amdgcn_s_sleep(1);
        if ((++sp & 255u) == 0u) { if (xb_ld(&bar[XB_TMO])) break; if (sp > XB_SPIN_CAP) { atomicAdd(&bar[XB_TMO], 1u); break; } }
    }
    nloc = mine > 0u ? mine : 1u; nx = cnt > 0u ? cnt : 1u;
}
__device__ __forceinline__ void xcd_barrier(const XcdBarrier& b) {
    asm volatile("s_waitcnt vmcnt(0)" ::: "memory");
    __syncthreads();
    if (threadIdx.x == 0) {
        unsigned* bar = b.bar;
        __builtin_amdgcn_s_waitcnt(0);
        unsigned nloc = b.st[0], nx = b.st[1];
        if (nloc == 0u) { xcd_barrier_complete(bar, b.x, nloc, nx); b.st[0] = nloc; b.st[1] = nx; }
        const unsigned old = xb_add(&bar[XB_XSUB(b.x)], 1u);
        const unsigned gen = old / nloc;
        if (old + 1u == (gen + 1u) * nloc) {
            __builtin_amdgcn_fence(__ATOMIC_RELEASE, "agent");
            asm volatile("s_waitcnt vmcnt(0)" ::: "memory");
            const unsigned og = xb_add(&bar[XB_TOP], 1u);
            const unsigned tg = og / nx;
            if (og + 1u == (tg + 1u) * nx) xb_add(&bar[XB_TOPGEN], 1u);
            else XB_SPIN(xb_ld(&bar[XB_TOPGEN]) == tg, bar);
            __builtin_amdgcn_fence(__ATOMIC_ACQUIRE, "agent");
            xb_add(&bar[XB_XGEN(b.x)], 1u);
            asm volatile("s_waitcnt vmcnt(0)" ::: "memory");
        } else {
            XB_SPIN(xb_ld(&bar[XB_XGEN(b.x)]) == gen, bar);
            __builtin_amdgcn_fence(__ATOMIC_ACQUIRE, "agent");
            asm volatile("s_waitcnt vmcnt(0)" ::: "memory");
        }
    }
    __syncthreads();
}

struct Args {
    const float *xp, *xs, *rel_bias, *pre_g, *post_g, *w_in, *conv_w, *conv_b, *fw1, *fb1, *fw2, *fb2, *fw3, *fb3, *fw4, *ffreq, *skip, *wba, *wbh, *wout;
    float* out; unsigned char* ws;
};

#define FDEV __device__ __forceinline__
#define FLAS __attribute__((address_space(3)))
#define FFT_OPAQUE(x) asm volatile("" : "+v"(x))
typedef float FC __attribute__((ext_vector_type(2)));
__device__ __forceinline__ float fft_cos_turns(float t) { return __builtin_amdgcn_cosf(t); }
__device__ __forceinline__ float fft_sin_turns(float t) { return __builtin_amdgcn_sinf(t); }

FDEV int fft_swz(int idx) { return idx ^ ((idx >> 4) & 15); }

FDEV FC fft_mulw16(FC t, int idx) {
    const float C1 = 0.92387953251128674f, S1 = 0.38268343236508977f, H = 0.70710678118654752f;
    FC r;
    if (idx == 0) { r = t; }
    else if (idx == 4) { r.x = t.y; r.y = -t.x; }
    else if (idx == 2) { r.x = (t.x + t.y) * H; r.y = (t.y - t.x) * H; }
    else if (idx == 6) { r.x = (t.y - t.x) * H; r.y = -(t.x + t.y) * H; }
    else {
        float c, s;
        if (idx == 1) { c = C1; s = S1; } else if (idx == 3) { c = S1; s = C1; } else if (idx == 5) { c = -S1; s = C1; } else { c = -C1; s = S1; }
        r.x = t.x * c + t.y * s; r.y = t.y * c - t.x * s;
    }
    return r;
}
template <int R> FDEV void fft_dft(FC (&a)[R]) {
#pragma unroll
    for (int len = R; len >= 2; len >>= 1) {
        const int half = len >> 1;
#pragma unroll
        for (int g0 = 0; g0 < R; g0 += len) {
#pragma unroll
            for (int k = 0; k < half; ++k) {
                const FC u = a[g0 + k], v = a[g0 + k + half];
                FC su, t; su.x = u.x + v.x; su.y = u.y + v.y; t.x = u.x - v.x; t.y = u.y - v.y;
                a[g0 + k] = su; a[g0 + k + half] = fft_mulw16(t, k * (16 / len));
            }
        }
    }
}
template <int R> FDEV int fft_bitrev(int j) { int r = 0;
#pragma unroll
    for (int b = 1, rb = R >> 1; b < R; b <<= 1, rb >>= 1) if (j & b) r |= rb; return r; }

template <int R> FDEV void fft_pass_load(const FLAS FC* D, int log2n, int log2s, int tid, FC (&v)[32]) {
    FFT_OPAQUE(tid);
    constexpr int LR = (R == 16) ? 4 : (R == 8) ? 3 : (R == 4) ? 2 : 1;
    const int n = 1 << log2n, nR = n >> LR;
#pragma unroll
    for (int u = 0; u < 32 / R; ++u) {
        const int bi = tid + 512 * u;
        const int sq = bi >> (log2n - LR), i = bi & (nR - 1);
        FC a[R];
#pragma unroll
        for (int k = 0; k < R; ++k) a[k] = D[fft_swz(sq * n + i + k * nR)];
        fft_dft<R>(a);
        const int ps = (i >> log2s) << log2s;
#pragma unroll
        for (int j = 0; j < R; ++j) {
            FC b = a[fft_bitrev<R>(j)];
            if (j > 0) {
                const float turns = (float)((j * ps) & (n - 1)) * (1.0f / (float)n);
                const float c = fft_cos_turns(turns), s = fft_sin_turns(turns);
                FC r; r.x = b.x * c + b.y * s; r.y = b.y * c - b.x * s; b = r;
            }
            v[u * R + j] = b;
        }
    }
}
template <int R> FDEV void fft_pass_store(FLAS FC* D, int log2n, int log2s, int tid, const FC (&v)[32]) {
    FFT_OPAQUE(tid);
    constexpr int LR = (R == 16) ? 4 : (R == 8) ? 3 : (R == 4) ? 2 : 1;
    const int n = 1 << log2n, nR = n >> LR;
#pragma unroll
    for (int u = 0; u < 32 / R; ++u) {
        const int bi = tid + 512 * u;
        const int sq = bi >> (log2n - LR), i = bi & (nR - 1);
        const int q = i & ((1 << log2s) - 1), p = i >> log2s;
#pragma unroll
        for (int j = 0; j < R; ++j) D[fft_swz(sq * n + q + ((R * p + j) << log2s))] = v[u * R + j];
    }
}

namespace pg8 {
constexpr int BM = 256, BK = 64, HALF = 128, HTB = HALF * BK * 2, STAGE_BYTES = 8 * HTB;
__host__ __device__ __forceinline__ int lds_byte(int r, int c) { const int st = (r >> 4) * 2 + (c >> 5), rr = r & 15, cc = c & 31, ob = rr * 64 + cc * 2; return st * 1024 + (ob ^ (((ob >> 9) & 1) << 5)); }
__host__ __device__ __forceinline__ void stage_rc(int b, int& R, int& C) { const int st = b / 1024, sb = b % 1024, swz = sb ^ (((sb >> 9) & 1) << 5); R = (st >> 1) * 16 + swz / 64; C = (st & 1) * 32 + (swz % 64) / 2; }
__host__ __device__ __forceinline__ int perm32(int rho) { const int n = rho >> 4, i = rho & 15; return 8 * (i >> 2) + 4 * n + (i & 3); }

struct GUnit { const char* A; const char* B; unsigned lda, ldb; int nt, mode; bf16* dst; int ldc; const bf16* aux; int ldaux; float scale; };
__device__ __forceinline__ void unit_order(int l, int nwg, int nM, int nN, int& pm, int& pn) {
    const int q = nwg / 8, xcd = l % 8, off = l / 8; const int wgid = xcd * q + off;
    const int nig = 8 * nN, gid = wgid / nig, fm = gid * 8, gsz = (nM - fm) < 8 ? (nM - fm) : 8;
    pm = fm + ((wgid % nig) % gsz); pn = (wgid % nig) / gsz;
}
__device__ __forceinline__ bool gemm_next(const Args& P, int ph, int hf, int i, int c, int G, GUnit& u) {
    unsigned char* ws = P.ws; const char* WT = (const char*)(ws + WS_WT); const char* XN = (const char*)(ws + WS_XN) + (size_t)hf * HTOK * 2048;
    unsigned char* R = ws + WS_R;
    u.aux = nullptr; u.ldaux = 0; u.scale = 1.f; u.mode = 0; u.lda = 2048; u.ldb = 2048; u.nt = 16;
    const int L = i * G + c;
    if (ph == 1) {
        if (L >= 1280) return false;
        if (L < 896) { int pm, pn; unit_order(L, 896, 64, 14, pm, pn);
            u.A = XN + (size_t)pm * 256 * 2048; u.B = WT + (size_t)pn * 256 * 2048;
            if (pn < 12) { u.dst = (bf16*)(R + R_QK) + (size_t)pm * 256 * 3072 + pn * 256; u.ldc = 3072; u.scale = ((pn & 3) < 2) ? 0.125f : 1.f; }
            else { u.dst = (bf16*)(R + R_GA) + (size_t)pm * 256 * 512 + (pn - 12) * 256; u.ldc = 512; u.mode = 1; }
        } else { int l = L - 896; const int g = l / 128; l -= g * 128; int pm, pn; unit_order(l, 128, 2, 64, pm, pn);
            const int r = (g == 0) ? 1 : (g == 1 ? 4 : 16), S = hf ? 4096 : 8192, tps = S / 256, seq = pn / tps, tq = (pn % tps) * 256, lr = S / r, cc = tq / lr, i0 = tq % lr;
            u.A = WT + (size_t)(3584 + g * 512 + pm * 256) * 2048;
            u.B = XN + (size_t)(seq * S + i0 * r + cc) * 2048; u.ldb = 2048u * r;
            u.dst = (bf16*)(R + R_VT) + (size_t)(g * 512 + pm * 256) * HTOK + pn * 256; u.ldc = HTOK; }
        return true;
    }
    if (ph == 3) {
        if (L >= 1024) return false; int pm, pn; unit_order(L, 1024, 16, 64, pm, pn);
        u.A = WT + (size_t)(5120 + pm * 256) * 2048; u.B = XN + (size_t)pn * 256 * 2048; u.ldc = HTOK;
        if (pm < 12) u.dst = (bf16*)(R + R_U) + (size_t)pm * 256 * HTOK + pn * 256;
        else { u.dst = (bf16*)(R + R_HS) + (size_t)(pm - 12) * 256 * HTOK + pn * 256; u.mode = 1; }
        return true;
    }
    if (ph == 6) {
        const int tile = c + (i >> 2) * G, sub = i & 3; if (tile >= 256) return false;
        const int pm = tile >> 2, pn = tile & 3;
        bf16* MGS = (bf16*)(R + R_MGS) + (size_t)pm * 256 * 2048 + pn * 256; bf16* MRG = (bf16*)(R + R_MRG) + (size_t)pm * 256 * 1024 + pn * 256;
        const char* OS = (const char*)P.out + (size_t)hf * 64 * MiB;
        if (sub < 2) { u.A = XN + (size_t)pm * 256 * 2048; u.B = WT + (size_t)(9216 + sub * 1024 + pn * 256) * 2048; u.dst = MGS + sub * 1024; u.ldc = 2048; u.mode = 2; }
        else if (sub == 2) { u.A = OS + O_AS + (size_t)pm * 256 * 1024; u.lda = 1024; u.B = (const char*)(ws + WS_WBA) + (size_t)pn * 256 * 1024; u.ldb = 1024; u.nt = 8;
            u.dst = MRG; u.ldc = 1024; u.aux = MGS; u.ldaux = 2048; u.mode = 3; }
        else { u.A = (const char*)(R + R_HS) + (size_t)pm * 256 * 2048; u.B = (const char*)(ws + WS_WBH) + (size_t)pn * 256 * 2048; u.dst = MRG; u.ldc = 1024; u.aux = MGS + 1024; u.ldaux = 2048; u.mode = 4; }
        return true;
    }
    if (L >= 256) return false;
    { int pm, pn; unit_order(L, 256, 64, 4, pm, pn);
      u.A = (const char*)(R + R_MRG) + (size_t)pm * 256 * 2048; u.B = (const char*)(ws + WS_WO) + (size_t)pn * 256 * 2048;
      u.dst = (bf16*)(R + R_OUT) + (size_t)pm * 256 * 1024 + pn * 256; u.ldc = 1024; }
    return true;
}

__device__ __forceinline__ void gemm_epi(const f32x4 (&acc)[2][2][4][2], const GUnit& u, int wr, int wc, int fr, int fq) {
    const int row0 = wr * 64 + fr, col0 = wc * 32 + 8 * fq;
#pragma unroll
    for (int ai = 0; ai < 2; ++ai)
#pragma unroll
        for (int m = 0; m < 4; ++m) {
            const int row = row0 + ai * HALF + m * 16;
            bf16* rowp = u.dst + (size_t)row * u.ldc + col0;
#pragma unroll
            for (int bj = 0; bj < 2; ++bj) {
                f32x4 v0 = acc[ai][bj][m][0], v1 = acc[ai][bj][m][1];
                float v[8] = {v0[0], v0[1], v0[2], v0[3], v1[0], v1[1], v1[2], v1[3]};
                if (u.mode == 0) {
#pragma unroll
                    for (int e = 0; e < 8; ++e) v[e] *= u.scale;
                } else if (u.mode == 1) {
#pragma unroll
                    for (int e = 0; e < 8; ++e) v[e] = v[e] * sigmoidf_(v[e]);
                } else if (u.mode == 2) {
#pragma unroll
                    for (int e = 0; e < 8; ++e) v[e] = sigmoidf_(v[e]);
                } else {
                    const u32x4 gw = *(const u32x4*)(u.aux + (size_t)row * u.ldaux + col0 + bj * HALF);
                    float g[8] = {bflo(gw.x), bfhi(gw.x), bflo(gw.y), bfhi(gw.y), bflo(gw.z), bfhi(gw.z), bflo(gw.w), bfhi(gw.w)};
                    if (u.mode == 3) {
#pragma unroll
                        for (int e = 0; e < 8; ++e) v[e] = g[e] * v[e];
                    } else {
                        const u32x4 pw = *(const u32x4*)(rowp + bj * HALF);
                        float p[8] = {bflo(pw.x), bfhi(pw.x), bflo(pw.y), bfhi(pw.y), bflo(pw.z), bfhi(pw.z), bflo(pw.w), bfhi(pw.w)};
#pragma unroll
                        for (int e = 0; e < 8; ++e) v[e] = p[e] + g[e] * v[e];
                    }
                }
                u32x4 w; w.x = pk2(v[0], v[1]); w.y = pk2(v[2], v[3]); w.z = pk2(v[4], v[5]); w.w = pk2(v[6], v[7]);
                *(u32x4*)(rowp + bj * HALF) = w;
            }
        }
}

__device__ __forceinline__ void gemm_phase(LAS unsigned char* lds, const Args& P, int ph, int hf, int c, int G) {
    int tid = threadIdx.x; asm volatile("" : "+v"(tid));
    const int wid = __builtin_amdgcn_readfirstlane(tid >> 6), lane = tid & 63, wr = wid >> 2, wc = wid & 3, fr = lane & 15, fq = lane >> 4;
    const unsigned ldsw = (unsigned)wid * 1024u;
    const int aoff = lds_byte(wr * 64 + fr, fq * 8), boff = lds_byte(wc * 32 + fr, fq * 8);
#define PG8_SA(b, h) (((b) * 2 + (h)) * HTB)
#define PG8_SB(b, h) ((4 + (b) * 2 + (h)) * HTB)
#define PG8_STAGE(bufoff, gbase, ld, ISB) do { int _t = tid; asm volatile("" : "+v"(_t)); _Pragma("unroll") for (int _i = 0; _i < 2; ++_i) { int _R, _C; stage_rc(_t * 16 + _i * 8192, _R, _C); \
        if (ISB) _R = (_R & ~31) + perm32(_R & 31); \
        __builtin_amdgcn_global_load_lds((const unsigned*)((const char*)(gbase) + (size_t)((unsigned)_R * (ld) + (unsigned)(_C * 2))), (LAS unsigned*)(lds + (bufoff) + ldsw + _i * 8192), 16, 0, 0); } } while (0)
#define RA 0
#define RB 1
#define PG8_LDA(dst, b, h) do { _Pragma("unroll") for (int m = 0; m < 4; ++m) _Pragma("unroll") for (int k = 0; k < 2; ++k) dst[m][k] = *(const LAS bf16x8*)(lds + PG8_SA(b, h) + aoff + m * 2048 + k * 1024); } while (0)
#define PG8_LDB(dst, b, h) do { _Pragma("unroll") for (int n = 0; n < 2; ++n) _Pragma("unroll") for (int k = 0; k < 2; ++k) dst[n][k] = *(const LAS bf16x8*)(lds + PG8_SB(b, h) + boff + n * 2048 + k * 1024); } while (0)
#define PG8_MMA(ai, bj, At, Bt) do { __builtin_amdgcn_s_setprio(1); _Pragma("unroll") for (int m = 0; m < 4; ++m) _Pragma("unroll") for (int n = 0; n < 2; ++n) _Pragma("unroll") for (int k = 0; k < 2; ++k) \
        acc[ai][bj][m][n] = __builtin_amdgcn_mfma_f32_16x16x32_bf16(Bt[n][k], At[m][k], acc[ai][bj][m][n], 0, 0, 0); __builtin_amdgcn_s_setprio(0); } while (0)
#define PG8_WAIT_V(n) asm volatile("s_waitcnt vmcnt(" #n ")" ::: "memory")
#define PG8_WAIT_L(n) asm volatile("s_waitcnt lgkmcnt(" #n ")" ::: "memory")
#define PG8_BAR __builtin_amdgcn_s_barrier()
#define PG8_SCHED __builtin_amdgcn_sched_barrier(0)
    int ui = 0;
    const char* cA; const char* cB; unsigned clda, cldb; int nt;
    { GUnit u0; if (!gemm_next(P, ph, hf, 0, c, G, u0)) return; cA = u0.A; cB = u0.B; clda = u0.lda; cldb = u0.ldb; nt = u0.nt; }
    f32x4 acc[2][2][4][2];
#pragma unroll
    for (int a = 0; a < 2; ++a)
#pragma unroll
        for (int b = 0; b < 2; ++b)
#pragma unroll
            for (int m = 0; m < 4; ++m)
#pragma unroll
                for (int n = 0; n < 2; ++n) acc[a][b][m][n] = (f32x4){0.f, 0.f, 0.f, 0.f};
    bf16x8 At[4][2], B0[2][2], B1[2][2];
    const size_t kstep = 128;
    {
        const size_t hA = (size_t)HALF * clda, hB = (size_t)HALF * cldb;
        PG8_STAGE(PG8_SB(0, 0), cB, cldb, RB); PG8_STAGE(PG8_SB(0, 1), cB + hB, cldb, RB); PG8_STAGE(PG8_SA(0, 0), cA, clda, RA); PG8_STAGE(PG8_SA(0, 1), cA + hA, clda, RA);
        if (wr == 1) PG8_BAR;
        PG8_WAIT_V(2); PG8_BAR;
        PG8_STAGE(PG8_SB(1, 0), cB + kstep, cldb, RB); PG8_STAGE(PG8_SA(1, 0), cA + kstep, clda, RA); PG8_STAGE(PG8_SB(1, 1), cB + hB + kstep, cldb, RB);
        PG8_WAIT_V(6); PG8_BAR;
    }
    for (;;) {
        bool has_next = false; const char* nA = cA; const char* nB = cB; unsigned nlda = clda, nldb = cldb; int nnt = nt;
        const size_t hA = (size_t)HALF * clda;
        for (int t = 0; t < nt; t += 2) {
            const bool last = (t == nt - 2);
            if (last) { GUnit un; has_next = gemm_next(P, ph, hf, ui + 1, c, G, un); if (has_next) { nA = un.A; nB = un.B; nlda = un.lda; nldb = un.ldb; nnt = un.nt; } }
            const char* a1 = cA + (size_t)(t + 1) * kstep;
            const char* a2 = last ? nA : cA + (size_t)(t + 2) * kstep; const char* b2 = last ? nB : cB + (size_t)(t + 2) * kstep;
            const unsigned lda2 = last ? nlda : clda, ldb2 = last ? nldb : cldb; const size_t hA2 = (size_t)HALF * lda2, hB2 = (size_t)HALF * ldb2;
            const char* a3 = a2 + kstep; const char* b3 = b2 + kstep;
            PG8_LDB(B0, 0, 0); PG8_LDB(B1, 0, 1); PG8_SCHED; PG8_LDA(At, 0, 0); PG8_STAGE(PG8_SA(1, 1), a1 + hA, clda, RA);
            PG8_WAIT_V(8); PG8_WAIT_L(0); PG8_BAR; PG8_MMA(0, 0, At, B0); PG8_MMA(0, 1, At, B1); PG8_BAR; PG8_SCHED;
            PG8_LDA(At, 0, 1); PG8_STAGE(PG8_SB(0, 0), b2, ldb2, RB); PG8_STAGE(PG8_SB(0, 1), b2 + hB2, ldb2, RB); PG8_STAGE(PG8_SA(0, 0), a2, lda2, RA);
            PG8_WAIT_V(8); PG8_WAIT_L(0); PG8_BAR; PG8_MMA(1, 0, At, B0); PG8_MMA(1, 1, At, B1); PG8_BAR; PG8_SCHED;
            PG8_LDB(B0, 1, 0); PG8_LDB(B1, 1, 1); PG8_SCHED; PG8_LDA(At, 1, 0); PG8_STAGE(PG8_SA(0, 1), a2 + hA2, lda2, RA);
            PG8_WAIT_V(8); PG8_WAIT_L(0); PG8_BAR; PG8_MMA(0, 0, At, B0); PG8_MMA(0, 1, At, B1); PG8_BAR; PG8_SCHED;
            PG8_LDA(At, 1, 1); PG8_STAGE(PG8_SB(1, 0), b3, ldb2, RB); PG8_STAGE(PG8_SB(1, 1), b3 + hB2, ldb2, RB); PG8_STAGE(PG8_SA(1, 0), a3, lda2, RA);
            PG8_WAIT_V(8); PG8_WAIT_L(0); PG8_BAR; PG8_MMA(1, 0, At, B0); PG8_MMA(1, 1, At, B1); PG8_BAR; PG8_SCHED;
        }
        if (wr == 0) PG8_BAR;
        { GUnit ue; (void)gemm_next(P, ph, hf, ui, c, G, ue); gemm_epi(acc, ue, wr, wc, fr, fq); }
        if (!has_next) break;
#pragma unroll
        for (int a = 0; a < 2; ++a)
#pragma unroll
            for (int b = 0; b < 2; ++b)
#pragma unroll
                for (int m = 0; m < 4; ++m)
#pragma unroll
                    for (int n = 0; n < 2; ++n) acc[a][b][m][n] = (f32x4){0.f, 0.f, 0.f, 0.f};
        cA = nA; cB = nB; clda = nlda; cldb = nldb; nt = nnt; ++ui;
        if (wr == 1) PG8_BAR;
    }
    PG8_WAIT_V(0);
    PG8_BAR;
#undef PG8_SA
#undef PG8_SB
#undef PG8_STAGE
#undef RA
#undef RB
#undef PG8_LDA
#undef PG8_LDB
#undef PG8_MMA
#undef PG8_WAIT_V
#undef PG8_WAIT_L
#undef PG8_BAR
#undef PG8_SCHED
}
}

__device__ __forceinline__ void p0_transpose_item(const float* W, int ldw, int c0, int ncols, int K, bf16* WT, int row_off, LAS float* scr, int item, int lane) {
    const int nblk = ncols / 32, kb = item / nblk, nb = item % nblk, k0 = 64 * kb, n0 = 32 * nb;
#pragma unroll 8
    for (int i = 0; i < 32; ++i) { const int kk = 2 * i + (lane >> 5); scr[kk * 33 + (lane & 31)] = W[(size_t)(k0 + kk) * ldw + c0 + n0 + (lane & 31)]; }
    LDS_WAIT(); asm volatile("" ::: "memory");
    const int c = lane & 7;
#pragma unroll
    for (int j = 0; j < 4; ++j) { const int n = (lane >> 3) + 8 * j; const LAS float* s = scr + (8 * c) * 33 + n;
        u32x4 o; o.x = pk2(s[0 * 33], s[1 * 33]); o.y = pk2(s[2 * 33], s[3 * 33]); o.z = pk2(s[4 * 33], s[5 * 33]); o.w = pk2(s[6 * 33], s[7 * 33]);
        *(u32x4*)(WT + (size_t)(row_off + n0 + n) * K + k0 + 8 * c) = o; }
    LDS_WAIT(); asm volatile("" ::: "memory");
}
__device__ __forceinline__ float rdlane(float v, int l) { return __builtin_bit_cast(float, __builtin_amdgcn_readlane(__builtin_bit_cast(int, v), l)); }

__device__ __forceinline__ void p0_prologue(const Args& P, LAS unsigned char* lds, int vcu, int G, int wave, int lane) {
    LAS float* scr = (LAS float*)(lds + wave * 16384);
    const int gw = vcu * NWAVES + wave, NGW = G * NWAVES;
    unsigned char* ws = P.ws;
    constexpr int IT_BLK = 16 * 16;
    constexpr int NIT = 22 * IT_BLK + (512 / 64) * (1024 / 32) + 2 * (1024 / 64) * (1024 / 32);
    for (int it = gw; it < NIT; it += NGW) {
        int r = it;
        if (r < 22 * IT_BLK) { const int b = r / IT_BLK; r -= b * IT_BLK;
            const int src = (b == 0) ? 0 : (b == 1) ? 3 : (b == 2) ? 1 : (b == 3) ? 4 : (b == 4) ? 2 : (b == 5) ? 5 : (b == 6) ? 9 : (b == 7) ? 6 : (b == 8) ? 7 : (b == 9) ? 8 : b;
            p0_transpose_item(P.w_in, 11264, src * 512, 512, 1024, (bf16*)(ws + WS_WT), b * 512, scr, r, lane); continue; }
        r -= 22 * IT_BLK;
        if (r < 256) { p0_transpose_item(P.wba, 1024, 0, 1024, 512, (bf16*)(ws + WS_WBA), 0, scr, r, lane); continue; }
        r -= 256;
        if (r < 512) { p0_transpose_item(P.wbh, 1024, 0, 1024, 1024, (bf16*)(ws + WS_WBH), 0, scr, r, lane); continue; }
        r -= 512;
        p0_transpose_item(P.wout, 1024, 0, 1024, 1024, (bf16*)(ws + WS_WO), 0, scr, r, lane);
    }
    {
        f32x4 g4[4];
#pragma unroll
        for (int j = 0; j < 4; ++j) g4[j] = ((const f32x4*)P.pre_g)[lane + 64 * j];
        for (int m = gw; m < MTOK; m += NGW) {
            const float* xrow = (m < HTOK) ? P.xp + (size_t)m * DM : P.xs + (size_t)(m - HTOK) * DM;
            const f32x4* xr = (const f32x4*)xrow + lane;
            f32x4 v[4]; float s = 0.f;
#pragma unroll
            for (int j = 0; j < 4; ++j) { v[j] = xr[64 * j]; s += (v[j].x * v[j].x + v[j].y * v[j].y) + (v[j].z * v[j].z + v[j].w * v[j].w); }
            const float rstd = 1.0f / sqrtf(wave_sum(s) * (1.f / DM) + EPS);
            unsigned long long* o8 = (unsigned long long*)((bf16*)(ws + WS_XN) + (size_t)m * DM) + lane;
#pragma unroll
            for (int j = 0; j < 4; ++j) o8[64 * j] = (unsigned long long)pk2(v[j].x * rstd * g4[j].x, v[j].y * rstd * g4[j].y) | ((unsigned long long)pk2(v[j].z * rstd * g4[j].z, v[j].w * rstd * g4[j].w) << 32);
        }
    }
    {
        const float fr = P.ffreq[lane], b1 = P.fb1[lane], b2 = P.fb2[lane], b3 = P.fb3[lane];
        for (int row = gw; row < 12288; row += NGW) {
            const int Lf = (row < 8192) ? 8192 : 4096, t = (row < 8192) ? row : row - 8192;
            const float tt = (float)t * (1.0f / (float)(Lf - 1));
            const float ang = (6.283185307179586f / (float)Lf) * (float)t;
            const int k = (lane >= 17) ? lane - 17 : lane - 1;
            const float band = 1e-4f + (float)(k & 15) * ((15.0f - 1e-4f) / 15.0f);
            const float a = ang * band;
            float z = (lane == 0) ? tt : ((lane <= 16) ? cosf(a) : -sinf(a));
            float acc = b1;
#pragma unroll
            for (int i = 0; i < 33; ++i) acc += rdlane(z, i) * P.fw1[i * 64 + lane];
            float h = sinf(fr * acc);
            acc = b2;
#pragma unroll 16
            for (int i = 0; i < 64; ++i) acc += rdlane(h, i) * P.fw2[i * 64 + lane];
            h = sinf(fr * acc);
            acc = b3;
#pragma unroll 16
            for (int i = 0; i < 64; ++i) acc += rdlane(h, i) * P.fw3[i * 64 + lane];
            h = sinf(fr * acc);
            ((float*)(ws + WS_HDN))[(size_t)row * 64 + lane] = h;
        }
    }
    {
        float* BT = (float*)(ws + WS_BT);
        for (int e = gw * 64 + lane; e < 3 * 8 * 129; e += NGW * 64) {
            const int g = e / (8 * 129), h = (e / 129) % 8, dd = e % 129;
            const int r = (g == 0) ? 1 : (g == 1 ? 4 : 16);
            const int rel = (dd - 64) * r; const int n = rel < 0 ? -rel : rel;
            const float nf = (float)(n > 1 ? n : 1);
            int large = 8 + (int)(logf(nf / 8.0f) / 4.852030263919617f * 8.0f);
            large = large < 15 ? large : 15;
            const int bucket = (rel > 0 ? 16 : 0) + (n < 8 ? n : large);
            BT[e] = P.rel_bias[bucket * 24 + g * 8 + h];
        }
    }
}

constexpr int AT_OB = 0, AT_LSE = 98304, AT_BT = 98304 + 3072;
__device__ __forceinline__ void attn_unit(const Args& P, LAS unsigned char* lds, int hf, int ch, int h, int tid, int wave, int lane) {
    const int S = hf ? 4096 : 8192, tps = S / 256, seq = ch / tps, T0 = (ch % tps) * 256, hs = seq * S;
    unsigned char* R = P.ws + WS_R;
    const bf16* QK = (const bf16*)(R + R_QK); const bf16* VT = (const bf16*)(R + R_VT); const bf16* GA = (const bf16*)(R + R_GA);
    bf16* AS = (bf16*)((unsigned char*)P.out + (size_t)hf * 64 * MiB + O_AS);
    LAS float* BTL = (LAS float*)(lds + AT_BT); LAS float* LSE = (LAS float*)(lds + AT_LSE);
    const float* BT = (const float*)(P.ws + WS_BT);
    if (tid < 3 * 129) { const int g = tid / 129, dd = tid % 129; BTL[g * 132 + dd] = BT[(g * 8 + h) * 129 + dd]; }
    __syncthreads();
    const int a = lane & 15, gq = lane >> 4;
    for (int wt = wave; wt < 48; wt += 8) {
        const int g = wt >> 4, j = wt & 15;
        const int r = (g == 0) ? 1 : (g == 1 ? 4 : 16);
        const int c = (g == 0) ? 0 : (g == 1 ? (j & 3) : j);
        const int i0 = (g == 0) ? (T0 + 16 * j) : (g == 1 ? (T0 / 4 + 16 * (j >> 2)) : (T0 / 16));
        const int lr = S / r;
        const bf16* qk_g = QK + g * 1024 + h * 64 + 8 * gq;
        const bf16* qp = qk_g + (size_t)(hs + (i0 + a) * r + c) * 3072;
        const bf16x8 q0 = *(const bf16x8*)qp, q1 = *(const bf16x8*)(qp + 32);
        f32x4 s[9];
#pragma unroll
        for (int kt = 0; kt < 9; ++kt) {
            int ki = i0 - 64 + 16 * kt + a; ki = ki < 0 ? 0 : (ki > lr - 1 ? lr - 1 : ki);
            const bf16* kp = qk_g + 512 + (size_t)(hs + ki * r + c) * 3072;
            const bf16x8 k0 = *(const bf16x8*)kp, k1 = *(const bf16x8*)(kp + 32);
            f32x4 z = {0.f, 0.f, 0.f, 0.f};
            z = __builtin_amdgcn_mfma_f32_16x16x32_bf16(k0, q0, z, 0, 0, 0);
            s[kt] = __builtin_amdgcn_mfma_f32_16x16x32_bf16(k1, q1, z, 0, 0, 0);
        }
        float mx = -1e30f;
#pragma unroll
        for (int kt = 0; kt < 9; ++kt)
#pragma unroll
            for (int rg = 0; rg < 4; ++rg) {
                const int kk = 16 * kt + 4 * gq + rg, dd = kk - a, ki = i0 - 64 + kk;
                const bool ok = (dd >= 0) && (dd <= 128) && (ki >= 0) && (ki < lr);
                const float v = ok ? s[kt][rg] + BTL[g * 132 + (dd < 0 ? 0 : (dd > 128 ? 128 : dd))] : -1e30f;
                s[kt][rg] = v; mx = fmaxf(mx, v);
            }
        mx = fmaxf(mx, __shfl_xor(mx, 16)); mx = fmaxf(mx, __shfl_xor(mx, 32));
        float ls = 0.f;
#pragma unroll
        for (int kt = 0; kt < 9; ++kt)
#pragma unroll
            for (int rg = 0; rg < 4; ++rg) { const float p = __expf(s[kt][rg] - mx); s[kt][rg] = p; ls += p; }
        ls += __shfl_xor(ls, 16); ls += __shfl_xor(ls, 32);
        f32x4 o[4];
#pragma unroll
        for (int dt = 0; dt < 4; ++dt) o[dt] = (f32x4){0.f, 0.f, 0.f, 0.f};
        const bf16* vt_g = VT + (size_t)(g * 512 + h * 64 + a) * HTOK + hs + c * lr;
#pragma unroll
        for (int pp = 0; pp < 5; ++pp) {
            const int kt0 = 2 * pp, kt1 = 2 * pp + 1;
            bf16x8 pf;
            { const unsigned w0 = pk2(s[kt0][0], s[kt0][1]), w1 = pk2(s[kt0][2], s[kt0][3]);
              unsigned w2 = 0u, w3 = 0u; if (kt1 < 9) { w2 = pk2(s[kt1 < 9 ? kt1 : 8][0], s[kt1 < 9 ? kt1 : 8][1]); w3 = pk2(s[kt1 < 9 ? kt1 : 8][2], s[kt1 < 9 ? kt1 : 8][3]); }
              const u32x4 pw = {w0, w1, w2, w3}; pf = __builtin_bit_cast(bf16x8, pw); }
            int ks0 = i0 - 64 + 16 * kt0 + 4 * gq; ks0 = ks0 < 0 ? 0 : (ks0 > lr - 4 ? lr - 4 : ks0);
            int ks1 = i0 - 64 + 16 * kt1 + 4 * gq; ks1 = ks1 < 0 ? 0 : (ks1 > lr - 4 ? lr - 4 : ks1);
#pragma unroll
            for (int dt = 0; dt < 4; ++dt) {
                const bf16* vp = vt_g + (size_t)(16 * dt) * HTOK;
                const u32x2 va = *(const u32x2*)(vp + ks0);
                u32x2 vb = {0u, 0u}; if (kt1 < 9) vb = *(const u32x2*)(vp + ks1);
                const u32x4 vw = {va.x, va.y, vb.x, vb.y};
                o[dt] = __builtin_amdgcn_mfma_f32_16x16x32_bf16(__builtin_bit_cast(bf16x8, vw), pf, o[dt], 0, 0, 0);
            }
        }
        const float inv = 1.0f / ls;
        const int tl = (i0 + a) * r + c - T0;
#pragma unroll
        for (int dt = 0; dt < 4; ++dt) {
            const u32x2 w = {pk2(o[dt][0] * inv, o[dt][1] * inv), pk2(o[dt][2] * inv, o[dt][3] * inv)};
            *(LAS u32x2*)(lds + AT_OB + ((g * 256 + tl) * 64 + 16 * dt + 4 * gq) * 2) = w;
        }
        if (gq == 0) LSE[g * 256 + tl] = mx + __logf(ls);
    }
    __syncthreads();
    for (int it = tid; it < 2048; it += NTHREADS) {
        const int tl = it >> 3, ck = it & 7;
        const float l0 = LSE[tl], l1 = LSE[256 + tl], l2 = LSE[512 + tl];
        const float m = fmaxf(l0, fmaxf(l1, l2));
        float w0 = __expf(l0 - m), w1 = __expf(l1 - m), w2 = __expf(l2 - m);
        const float iw = 1.0f / (w0 + w1 + w2); w0 *= iw; w1 *= iw; w2 *= iw;
        const u32x4 a0 = *(const LAS u32x4*)(lds + AT_OB + ((0 * 256 + tl) * 64 + 8 * ck) * 2);
        const u32x4 a1 = *(const LAS u32x4*)(lds + AT_OB + ((1 * 256 + tl) * 64 + 8 * ck) * 2);
        const u32x4 a2 = *(const LAS u32x4*)(lds + AT_OB + ((2 * 256 + tl) * 64 + 8 * ck) * 2);
        const size_t row = (size_t)(hs + T0 + tl);
        const u32x4 gv = *(const u32x4*)(GA + row * 512 + h * 64 + 8 * ck);
        u32x4 ov;
#define AT_MIX(F) pk2((w0 * bflo(a0.F) + w1 * bflo(a1.F) + w2 * bflo(a2.F)) * bflo(gv.F), (w0 * bfhi(a0.F) + w1 * bfhi(a1.F) + w2 * bfhi(a2.F)) * bfhi(gv.F))
        ov.x = AT_MIX(x); ov.y = AT_MIX(y); ov.z = AT_MIX(z); ov.w = AT_MIX(w);
#undef AT_MIX
        *(u32x4*)(AS + row * 512 + h * 64 + 8 * ck) = ov;
    }
    __syncthreads();
}

__device__ __forceinline__ void fft16k(LAS FC* Dd, int log2n, int tid) {
    FC v[32];
    fft_pass_load<16>(Dd, log2n, 0, tid, v); __syncthreads(); fft_pass_store<16>(Dd, log2n, 0, tid, v); __syncthreads();
    fft_pass_load<16>(Dd, log2n, 4, tid, v); __syncthreads(); fft_pass_store<16>(Dd, log2n, 4, tid, v); __syncthreads();
    fft_pass_load<16>(Dd, log2n, 8, tid, v); __syncthreads(); fft_pass_store<16>(Dd, log2n, 8, tid, v); __syncthreads();
    if (log2n == 14) { fft_pass_load<4>(Dd, log2n, 12, tid, v); __syncthreads(); fft_pass_store<4>(Dd, log2n, 12, tid, v); __syncthreads(); }
    else             { fft_pass_load<2>(Dd, log2n, 12, tid, v); __syncthreads(); fft_pass_store<2>(Dd, log2n, 12, tid, v); __syncthreads(); }
}
__device__ __forceinline__ float sconv(const bf16* row, int t, int Ls, float w0, float w1, float w2, float b) {
    const float um = (t > 0) ? bf2f(row[t - 1]) : 0.f, u0 = bf2f(row[t]), up = (t < Ls - 1) ? bf2f(row[t + 1]) : 0.f;
    return um * w0 + u0 * w1 + up * w2 + b;
}
__device__ __forceinline__ void hyena_unit(const Args& P, LAS unsigned char* lds, int hf, int c, int tid) {
    const int Ls = hf ? 4096 : 8192, log2n = hf ? 13 : 14, N = 2 * Ls;
    LAS FC* Dd = (LAS FC*)lds;
    LAS float* W4L = (LAS float*)(lds + HY_W4_OFF);
    unsigned char* R = P.ws + WS_R;
    const bf16* U = (const bf16*)(R + R_U); const bf16* GH = (const bf16*)(R + R_HS); bf16* HS2 = (bf16*)((unsigned char*)P.out + (size_t)hf * 64 * MiB + O_HST);
    FC* Xs = (FC*)(R + R_XS) + (size_t)blockIdx.x * 16384;
    FC* ZZ = (FC*)((unsigned char*)P.out + (size_t)hf * 64 * MiB + O_ZZ) + (size_t)blockIdx.x * 8192;
    const float* hdn = (const float*)(P.ws + WS_HDN) + (hf ? (size_t)8192 * 64 : 0);
    if (tid < 256) { const int q = tid & 3, qs = (q == 1) ? 2 : (q == 2 ? 1 : q); W4L[tid] = P.fw4[(size_t)(tid >> 2) * 4096 + qs * 1024 + c]; }
    __syncthreads();
    {
        const float delta = fabsf(-3.0701134573253945f + (float)c * ((-15.350567286626973f + 3.0701134573253945f) / 1023.0f));
        asm volatile("" : "+v"(tid));
        unsigned wb = HY_W4_OFF; asm volatile("" : "+v"(wb));
#pragma unroll 1
        for (int t = tid; t < Ls; t += NTHREADS) {
            asm volatile("" ::: "memory");
            const f32x4* hr = (const f32x4*)(hdn + (size_t)t * 64);
            FC af = {0.f, 0.f}, ab = {0.f, 0.f};
#pragma unroll 4
            for (int j4 = 0; j4 < 16; ++j4) {
                const f32x4 hv = hr[j4];
#pragma unroll
                for (int jj = 0; jj < 4; ++jj) { const f32x4 w = *(const LAS f32x4*)(lds + wb + (j4 * 4 + jj) * 16);
                    const FC wf = {w.x, w.y}, wk = {w.z, w.w}; const float hs_ = hv[jj]; af += wf * hs_; ab += wk * hs_; }
            }
            const float dec = expf(-((float)t * (1.0f / (float)(Ls - 1))) * delta);
            Dd[fft_swz(t)] = af * dec;
            if (t >= 1) Dd[fft_swz(N - t)] = ab * dec;
        }
        if (tid == 0) { FC z; z.x = 0.f; z.y = 0.f; Dd[fft_swz(Ls)] = z; }
        if (hf) for (int e = tid; e < 8192; e += NTHREADS) { FC z; z.x = 0.f; z.y = 0.f; Dd[fft_swz(8192 + e)] = z; }
    }
    __syncthreads();
    fft16k(Dd, log2n, tid);
    asm volatile("" : "+v"(tid));
    for (int f = tid; f < N; f += NTHREADS) Xs[f] = Dd[fft_swz(f)];
    __syncthreads();
    const float* cw = P.conv_w; const float* cb = P.conv_b;
    const float wv0 = cw[c], wv1 = cw[3072 + c], wv2 = cw[6144 + c], bv = cb[c];
    const float wa0 = cw[1024 + c], wa1 = cw[3072 + 1024 + c], wa2 = cw[6144 + 1024 + c], ba = cb[1024 + c];
    const float wb0 = cw[2048 + c], wb1 = cw[3072 + 2048 + c], wb2 = cw[6144 + 2048 + c], bb = cb[2048 + c];
    const float sk1 = P.skip[c], sk2 = P.skip[1024 + c];
    const bf16* Uv = U + (size_t)c * HTOK; const bf16* Ua = U + (size_t)(1024 + c) * HTOK; const bf16* Ub = U + (size_t)(2048 + c) * HTOK;
    const bf16* Gc = GH + (size_t)c * HTOK; bf16* Hc = HS2 + (size_t)c * HTOK;
    const float invN = 1.0f / (float)N;
    asm volatile("" : "+v"(tid));
#pragma unroll 2
    for (int k = 0; k < 16; ++k) { const int e = tid + 512 * k, bp = e / Ls, t = e - bp * Ls;
        FC z; z.x = sconv(Uv + (size_t)(2 * bp) * Ls, t, Ls, wv0, wv1, wv2, bv); z.y = sconv(Uv + (size_t)(2 * bp + 1) * Ls, t, Ls, wv0, wv1, wv2, bv);
        Dd[fft_swz(bp * N + t)] = z; FC zero; zero.x = 0.f; zero.y = 0.f; Dd[fft_swz(bp * N + Ls + t)] = zero; }
    __syncthreads();
#pragma unroll 1
    for (int ord = 0; ord < 2; ++ord) {
        fft16k(Dd, log2n, tid);
        asm volatile("" : "+v"(tid));
#pragma unroll 2
        for (int idx = tid; idx < 16384; idx += NTHREADS) {
            const int f = idx & (N - 1);
            const FC x1 = Xs[f], x2 = Xs[(N - f) & (N - 1)];
            FC Kf;
            if (ord == 0) { Kf.x = 0.5f * (x1.x + x2.x); Kf.y = 0.5f * (x1.y - x2.y); }
            else { Kf.x = 0.5f * (x1.y + x2.y); Kf.y = -0.5f * (x1.x - x2.x); }
            Kf.x *= invN; Kf.y *= invN;
            const FC zv = Dd[fft_swz(idx)];
            FC y; y.x = zv.x * Kf.x - zv.y * Kf.y; y.y = -(zv.x * Kf.y + zv.y * Kf.x);
            Dd[fft_swz(idx)] = y;
        }
        __syncthreads();
        fft16k(Dd, log2n, tid);
        asm volatile("" : "+v"(tid));
        if (ord == 0) {
#pragma unroll 2
            for (int k = 0; k < 16; ++k) { const int e = tid + 512 * k, bp = e / Ls, t = e - bp * Ls;
                const FC yv = Dd[fft_swz(bp * N + t)];
                const bf16* r0 = Uv + (size_t)(2 * bp) * Ls; const bf16* r1 = Uv + (size_t)(2 * bp + 1) * Ls;
                const float z0 = sconv(r0, t, Ls, wv0, wv1, wv2, bv), z1 = sconv(r1, t, Ls, wv0, wv1, wv2, bv);
                const float x0 = sconv(Ua + (size_t)(2 * bp) * Ls, t, Ls, wa0, wa1, wa2, ba), x1 = sconv(Ua + (size_t)(2 * bp + 1) * Ls, t, Ls, wa0, wa1, wa2, ba);
                FC q; q.x = x0 * (yv.x + sk1 * z0); q.y = x1 * (-yv.y + sk1 * z1);
                ZZ[e] = q; Dd[fft_swz(bp * N + t)] = q; FC zero; zero.x = 0.f; zero.y = 0.f; Dd[fft_swz(bp * N + Ls + t)] = zero; }
            __syncthreads();
        } else {
#pragma unroll 2
            for (int k = 0; k < 16; ++k) { const int e = tid + 512 * k, bp = e / Ls, t = e - bp * Ls;
                const FC yv = Dd[fft_swz(bp * N + t)]; const FC zq = ZZ[e];
                const float x0 = sconv(Ub + (size_t)(2 * bp) * Ls, t, Ls, wb0, wb1, wb2, bb), x1 = sconv(Ub + (size_t)(2 * bp + 1) * Ls, t, Ls, wb0, wb1, wb2, bb);
                const float h0 = x0 * (yv.x + sk2 * zq.x), h1 = x1 * (-yv.y + sk2 * zq.y);
                const size_t i0_ = (size_t)(2 * bp) * Ls + t, i1_ = (size_t)(2 * bp + 1) * Ls + t;
                Hc[i0_] = (bf16)f2bf(h0 * bf2f(Gc[i0_])); Hc[i1_] = (bf16)f2bf(h1 * bf2f(Gc[i1_])); }
            __syncthreads();
        }
    }
}

__device__ __forceinline__ void transpose_phase(const Args& P, LAS unsigned char* lds, int hf, int vcu, int G, int tid) {
    const bf16* HS = (const bf16*)((unsigned char*)P.out + (size_t)hf * 64 * MiB + O_HST);
    bf16* HST = (bf16*)(P.ws + WS_R + R_HS);
    LAS bf16* T = (LAS bf16*)lds;
    for (int tile = vcu; tile < 16 * 64; tile += G) {
        const int cb = tile >> 6, tb = tile & 63;
#pragma unroll
        for (int ps = 0; ps < 4; ++ps) { const int rw = (tid >> 5) + 16 * ps, pc = tid & 31;
            const u32x4 v = *(const u32x4*)(HS + (size_t)(cb * 64 + rw) * HTOK + tb * 256 + pc * 8);
            const unsigned w[4] = {v.x, v.y, v.z, v.w};
#pragma unroll
            for (int e = 0; e < 4; ++e) { T[(pc * 8 + 2 * e) * 72 + rw] = (bf16)(w[e] & 0xffffu); T[(pc * 8 + 2 * e + 1) * 72 + rw] = (bf16)(w[e] >> 16); } }
        __syncthreads();
#pragma unroll
        for (int ps = 0; ps < 4; ++ps) { const int it = tid + 512 * ps, tk = it >> 3, ck = it & 7;
            const u32x4 v = *(const LAS u32x4*)(T + tk * 72 + ck * 8);
            *(u32x4*)(HST + (size_t)(tb * 256 + tk) * 1024 + cb * 64 + ck * 8) = v; }
        __syncthreads();
    }
}

__device__ __forceinline__ void norm_phase(const Args& P, int hf, int vcu, int G, int wave, int lane) {
    const bf16* OUT = (const bf16*)(P.ws + WS_R + R_OUT);
    const float* x = hf ? P.xs : P.xp; float* y = P.out + (size_t)hf * HTOK * DM;
    const int gw = vcu * NWAVES + wave, NGW = G * NWAVES;
    f32x4 g4[4];
#pragma unroll
    for (int j = 0; j < 4; ++j) g4[j] = ((const f32x4*)P.post_g)[lane + 64 * j];
    for (int m = gw; m < HTOK; m += NGW) {
        const u32x2* orow = (const u32x2*)(OUT + (size_t)m * DM) + lane;
        f32x4 v[4]; float s = 0.f;
#pragma unroll
        for (int j = 0; j < 4; ++j) { const u32x2 w = orow[64 * j]; v[j] = (f32x4){bflo(w.x), bfhi(w.x), bflo(w.y), bfhi(w.y)}; s += (v[j].x * v[j].x + v[j].y * v[j].y) + (v[j].z * v[j].z + v[j].w * v[j].w); }
        const float rstd = 1.0f / sqrtf(wave_sum(s) * (1.f / DM) + EPS);
        const f32x4* xr = (const f32x4*)(x + (size_t)m * DM) + lane; f32x4* yr = (f32x4*)(y + (size_t)m * DM) + lane;
#pragma unroll
        for (int j = 0; j < 4; ++j) { const f32x4 xv = xr[64 * j]; yr[64 * j] = xv + v[j] * rstd * g4[j]; }
    }
}

__global__ void __launch_bounds__(NTHREADS, 2) mk_fwd(const Args P) {
    extern __shared__ __attribute__((aligned(16))) unsigned char lds_raw[];
    cg::grid_group grid = cg::this_grid();
    LAS unsigned char* lds = (LAS unsigned char*)lds_raw;
    volatile LAS unsigned* MISC = (volatile LAS unsigned*)(lds + MISC_OFF);
    const int tid = threadIdx.x, lane = tid & 63, wave = __builtin_amdgcn_readfirstlane(tid >> 6);
    const int G = gridDim.x, bx = blockIdx.x;
    const int vcu = (G % 8 == 0) ? (bx % 8) * (G / 8) + bx / 8 : bx;
    for (int u = tid; u < (LDS_BYTES - RING_BYTES) / 4; u += NTHREADS) ((LAS unsigned*)(lds + RING_BYTES))[u] = 0u;
    __syncthreads();
    XcdBarrier bar = xcd_barrier_post((unsigned*)(P.ws + WS_CTL) + 4096, MISC + 8);
#ifndef NO_P0
    p0_prologue(P, lds, vcu, G, wave, lane);
#ifdef REP_P0
    __syncthreads(); p0_prologue(P, lds, vcu, G, wave, lane);
#endif
#endif
    grid.sync();
    int rep = 0; (void)rep;
#pragma unroll 1
    for (int hf = 0; hf < 2; ++hf) {
#pragma unroll 1
        for (int ph = 1; ph <= 8; ++ph) {
            int tq = threadIdx.x; asm volatile("" : "+v"(tq));
            const int lq = tq & 63, wq = __builtin_amdgcn_readfirstlane(tq >> 6);
            if (ph == 1 || ph == 3 || ph == 6 || ph == 7) {
#ifndef NO_GEMM
                pg8::gemm_phase(lds, P, ph, hf, bx, G);
#endif
            } else if (ph == 2) {
#ifndef NO_ATTN
                for (int u = bx; u < 512; u += G) attn_unit(P, lds, hf, u >> 3, u & 7, tq, wq, lq);
#endif
            } else if (ph == 4) {
#ifndef NO_HY
                for (int c = bx; c < 1024; c += G) hyena_unit(P, lds, hf, c, tq);
#endif
            } else if (ph == 5) {
                transpose_phase(P, lds, hf, vcu, G, tq);
            } else {
                norm_phase(P, hf, vcu, G, wq, lq);
            }
            if (!(hf == 1 && ph == 8)) xcd_barrier(bar);
#ifdef REP_PH
            if (ph == REP_PH && rep == 0) { rep = 1; --ph; } else rep = 0;
#endif
        }
    }
}

extern "C" void kernel_launch(void* const* d_in, const int* in_sizes, int n_in, void* d_out, int out_size, void* d_ws, size_t ws_size, hipStream_t stream) {
    static int grid = 0;
    if (grid == 0) {
        int dev = 0, cus = 0, per_cu = 0;
        (void)hipGetDevice(&dev);
        (void)hipDeviceGetAttribute(&cus, hipDeviceAttributeMultiprocessorCount, dev);
        (void)hipFuncSetAttribute((const void*)mk_fwd, hipFuncAttributeMaxDynamicSharedMemorySize, LDS_BYTES);
        (void)hipOccupancyMaxActiveBlocksPerMultiprocessor(&per_cu, (const void*)mk_fwd, NTHREADS, LDS_BYTES);
        (void)hipGetLastError();
        grid = cus;
        if (per_cu < 1 || n_in != 20 || ws_size < 256 * MiB) { fprintf(stderr, "kernel_launch: per_cu %d n_in %d ws %zu: unsupported\n", per_cu, n_in, ws_size); grid = -1; }
    }
    if (grid < 0) return;
    (void)hipMemsetAsync(d_ws, 0, 1u << 20, stream);
    Args a{};
    { const float** f = (const float**)&a; for (int i = 0; i < 20; ++i) f[i] = (const float*)d_in[i]; }
    a.out = (float*)d_out; a.ws = (unsigned char*)d_ws;
    void* kargs[] = {&a};
    hipError_t e = hipLaunchCooperativeKernel((const void*)mk_fwd, dim3(grid), dim3(NTHREADS), kargs, LDS_BYTES, stream);
    if (e != hipSuccess) fprintf(stderr, "cooperative launch failed: %s (grid %d)\n", hipGetErrorString(e), grid);
}
```

```cpp
#include <hip/hip_runtime.h>
#include <hip/hip_cooperative_groups.h>
#include <cstdio>
#include <cstdint>
namespace cg = cooperative_groups;

#define GAS __attribute__((address_space(1)))
#define LAS __attribute__((address_space(3)))
typedef unsigned short bf16;
typedef short bf16x8 __attribute__((ext_vector_type(8)));
typedef short s16x4 __attribute__((ext_vector_type(4)));
typedef float f32x4 __attribute__((ext_vector_type(4)));
typedef unsigned u32x4 __attribute__((ext_vector_type(4)));
typedef unsigned u32x2 __attribute__((ext_vector_type(2)));

constexpr int NWAVES = 8, NTHREADS = 512;
constexpr int LDS_BYTES = 147456;
constexpr int RING_BYTES = 131072;
constexpr int MISC_OFF = RING_BYTES + 320;
constexpr int HY_W4_OFF = RING_BYTES + 2048;
constexpr int DM = 1024, MTOK = 32768, HTOK = 16384;
constexpr float EPS = 1e-6f;
constexpr size_t MiB = (size_t)1 << 20;
constexpr size_t WS_CTL = 0, WS_WT = 1 * MiB, WS_WBA = 23 * MiB, WS_WBH = 24 * MiB, WS_WO = 26 * MiB, WS_HDN = 28 * MiB, WS_BT = 31 * MiB, WS_XN = 32 * MiB, WS_R = 96 * MiB;
constexpr size_t R_QK = 0, R_VT = 96 * MiB, R_GA = 144 * MiB;
constexpr size_t R_U = 0, R_HS = 96 * MiB, R_XS = 128 * MiB;
constexpr size_t R_MGS = 0, R_MRG = 64 * MiB, R_OUT = 96 * MiB;
constexpr size_t O_AS = 0, O_HST = 16 * MiB, O_ZZ = 48 * MiB;

__device__ __forceinline__ unsigned f2bf(float f) { unsigned u = __builtin_bit_cast(unsigned, f); return (u + 0x7fffu + ((u >> 16) & 1u)) >> 16; }
__device__ __forceinline__ unsigned pk2(float lo, float hi) { return f2bf(lo) | (f2bf(hi) << 16); }
__device__ __forceinline__ float bf2f(unsigned h) { return __builtin_bit_cast(float, h << 16); }
__device__ __forceinline__ float bflo(unsigned w) { return __builtin_bit_cast(float, w << 16); }
__device__ __forceinline__ float bfhi(unsigned w) { return __builtin_bit_cast(float, w & 0xffff0000u); }
__device__ __forceinline__ float sigmoidf_(float x) { return __builtin_amdgcn_rcpf(1.0f + __expf(-x)); }
__device__ __forceinline__ float wave_sum(float v) {
#pragma unroll
    for (int o = 1; o < 64; o <<= 1) v += __shfl_xor(v, o);
    return v;
}
#define LDS_WAIT() asm volatile("s_waitcnt lgkmcnt(0)" ::: "memory")

#define XB_TMO      128
#define XB_XCNT(j)  (256  + 64 * (j))
#define XB_XSUB(j)  (1280 + 64 * (j))
#define XB_XGEN(j)  (2304 + 64 * (j))
#define XB_TOP      3328
#define XB_TOPGEN   3392
#define XCD_BAR_WORDS 3456
#define XB_SPIN_CAP (1u << 18)
__device__ __forceinline__ unsigned xb_ld(unsigned* p)              { return __hip_atomic_load(p, __ATOMIC_RELAXED, __HIP_MEMORY_SCOPE_AGENT); }
__device__ __forceinline__ unsigned xb_add(unsigned* p, unsigned v) { return __hip_atomic_fetch_add(p, v, __ATOMIC_RELAXED, __HIP_MEMORY_SCOPE_AGENT); }
__device__ __forceinline__ unsigned xb_xcc_id() { return (unsigned)__builtin_amdgcn_s_getreg((3 << 11) | 20) & 0xFu; }
#define XB_SPIN(cond, bar) do { unsigned _sp = 0; while (cond) { __builtin_amdgcn_s_sleep(1); \
    if ((++_sp & 255u) == 0u) { if (xb_ld(&(bar)[XB_TMO])) break; if (_sp > XB_SPIN_CAP) { atomicAdd(&(bar)[XB_TMO], 1u); break; } } } } while (0)
struct XcdBarrier { unsigned* bar; unsigned x; volatile LAS unsigned* st; };
__device__ __forceinline__ XcdBarrier xcd_barrier_post(unsigned* bar, volatile LAS unsigned* st) {
    XcdBarrier b; b.bar = bar; b.x = xb_xcc_id(); b.st = st;
    if (threadIdx.x == 0) (void)xb_add(&bar[XB_XCNT(b.x)], 1u);
    return b;
}
__device__ __forceinline__ void xcd_barrier_complete(unsigned* bar, unsigned x, unsigned& nloc, unsigned& nx) {
    const unsigned G = gridDim.x * gridDim.y * gridDim.z;
    unsigned sum, cnt, mine, sp = 0u;
    for (;;) {
        sum = 0u; cnt = 0u; mine = 0u;
#pragma unroll
        for (unsigned j = 0; j < 16; ++j) { const unsigned c = xb_ld(&bar[XB_XCNT(j)]); sum += c; cnt += (c > 0u) ? 1u : 0u; mine = (j == x) ? c : mine; }
        if (sum == G) break;
        __builtin_amdgcn_s_sleep(1);
        if ((++sp & 255u) == 0u) { if (xb_ld(&bar[XB_TMO])) break; if (sp > XB_SPIN_CAP) { atomicAdd(&bar[XB_TMO], 1u); break; } }
    }
    nloc = mine > 0u ? mine : 1u; nx = cnt > 0u ? cnt : 1u;
}
__device__ __forceinline__ void xcd_barrier(const XcdBarrier& b) {
    asm volatile("s_waitcnt vmcnt(0)" ::: "memory");
    __syncthreads();
    if (threadIdx.x == 0) {
        unsigned* bar = b.bar;
        __builtin_amdgcn_s_waitcnt(0);
        unsigned nloc = b.st[0], nx = b.st[1];
        if (nloc == 0u) { xcd_barrier_complete(bar, b.x, nloc, nx); b.st[0] = nloc; b.st[1] = nx; }
        const unsigned old = xb_add(&bar[XB_XSUB(b.x)], 1u);
        const unsigned gen = old / nloc;
        if (old + 1u == (gen + 1u) * nloc) {
            __builtin_amdgcn_fence(__ATOMIC_RELEASE, "agent");
            asm volatile("s_waitcnt vmcnt(0)" ::: "memory");
            const unsigned og = xb_add(&bar[XB_TOP], 1u);
            const unsigned tg = og / nx;
            if (og + 1u == (tg + 1u) * nx) xb_add(&bar[XB_TOPGEN], 1u);
            else XB_SPIN(xb_ld(&bar[XB_TOPGEN]) == tg, bar);
            __builtin_amdgcn_fence(__ATOMIC_ACQUIRE, "agent");
            xb_add(&bar[XB_XGEN(b.x)], 1u);
            asm volatile("s_waitcnt vmcnt(0)" ::: "memory");
        } else {
            XB_SPIN(xb_ld(&bar[XB_XGEN(b.x)]) == gen, bar);
            __builtin_amdgcn_fence(__ATOMIC_ACQUIRE, "agent");
            asm volatile("s_waitcnt vmcnt(0)" ::: "memory");
        }
    }
    __syncthreads();
}

struct Args {
    const float *xp, *xs, *rel_bias, *pre_g, *post_g, *w_in, *conv_w, *conv_b, *fw1, *fb1, *fw2, *fb2, *fw3, *fb3, *fw4, *ffreq, *skip, *wba, *wbh, *wout;
    float* out; unsigned char* ws;
};

#define FDEV __device__ __forceinline__
#define FLAS __attribute__((address_space(3)))
#define FFT_OPAQUE(x) asm volatile("" : "+v"(x))
typedef float FC __attribute__((ext_vector_type(2)));
__device__ __forceinline__ float fft_cos_turns(float t) { return __builtin_amdgcn_cosf(t); }
__device__ __forceinline__ float fft_sin_turns(float t) { return __builtin_amdgcn_sinf(t); }

FDEV int fft_swz(int idx) { return idx ^ ((idx >> 4) & 15); }

FDEV FC fft_mulw16(FC t, int idx) {
    const float C1 = 0.92387953251128674f, S1 = 0.38268343236508977f, H = 0.70710678118654752f;
    FC r;
    if (idx == 0) { r = t; }
    else if (idx == 4) { r.x = t.y; r.y = -t.x; }
    else if (idx == 2) { r.x = (t.x + t.y) * H; r.y = (t.y - t.x) * H; }
    else if (idx == 6) { r.x = (t.y - t.x) * H; r.y = -(t.x + t.y) * H; }
    else {
        float c, s;
        if (idx == 1) { c = C1; s = S1; } else if (idx == 3) { c = S1; s = C1; } else if (idx == 5) { c = -S1; s = C1; } else { c = -C1; s = S1; }
        r.x = t.x * c + t.y * s; r.y = t.y * c - t.x * s;
    }
    return r;
}
template <int R> FDEV void fft_dft(FC (&a)[R]) {
#pragma unroll
    for (int len = R; len >= 2; len >>= 1) {
        const int half = len >> 1;
#pragma unroll
        for (int g0 = 0; g0 < R; g0 += len) {
#pragma unroll
            for (int k = 0; k < half; ++k) {
                const FC u = a[g0 + k], v = a[g0 + k + half];
                FC su, t; su.x = u.x + v.x; su.y = u.y + v.y; t.x = u.x - v.x; t.y = u.y - v.y;
                a[g0 + k] = su; a[g0 + k + half] = fft_mulw16(t, k * (16 / len));
            }
        }
    }
}
template <int R> FDEV int fft_bitrev(int j) { int r = 0;
#pragma unroll
    for (int b = 1, rb = R >> 1; b < R; b <<= 1, rb >>= 1) if (j & b) r |= rb; return r; }

template <int R> FDEV void fft_pass_load(const FLAS FC* D, int log2n, int log2s, int tid, FC (&v)[32]) {
    FFT_OPAQUE(tid);
    constexpr int LR = (R == 16) ? 4 : (R == 8) ? 3 : (R == 4) ? 2 : 1;
    const int n = 1 << log2n, nR = n >> LR;
#pragma unroll
    for (int u = 0; u < 32 / R; ++u) {
        const int bi = tid + 512 * u;
        const int sq = bi >> (log2n - LR), i = bi & (nR - 1);
        FC a[R];
#pragma unroll
        for (int k = 0; k < R; ++k) a[k] = D[fft_swz(sq * n + i + k * nR)];
        fft_dft<R>(a);
        const int ps = (i >> log2s) << log2s;
#pragma unroll
        for (int j = 0; j < R; ++j) {
            FC b = a[fft_bitrev<R>(j)];
            if (j > 0) {
                const float turns = (float)((j * ps) & (n - 1)) * (1.0f / (float)n);
                const float c = fft_cos_turns(turns), s = fft_sin_turns(turns);
                FC r; r.x = b.x * c + b.y * s; r.y = b.y * c - b.x * s; b = r;
            }
            v[u * R + j] = b;
        }
    }
}
template <int R> FDEV void fft_pass_store(FLAS FC* D, int log2n, int log2s, int tid, const FC (&v)[32]) {
    FFT_OPAQUE(tid);
    constexpr int LR = (R == 16) ? 4 : (R == 8) ? 3 : (R == 4) ? 2 : 1;
    const int n = 1 << log2n, nR = n >> LR;
#pragma unroll
    for (int u = 0; u < 32 / R; ++u) {
        const int bi = tid + 512 * u;
        const int sq = bi >> (log2n - LR), i = bi & (nR - 1);
        const int q = i & ((1 << log2s) - 1), p = i >> log2s;
#pragma unroll
        for (int j = 0; j < R; ++j) D[fft_swz(sq * n + q + ((R * p + j) << log2s))] = v[u * R + j];
    }
}

namespace pg8 {
constexpr int BM = 256, BK = 64, HALF = 128, HTB = HALF * BK * 2, STAGE_BYTES = 8 * HTB;
__host__ __device__ __forceinline__ int lds_byte(int r, int c) { const int st = (r >> 4) * 2 + (c >> 5), rr = r & 15, cc = c & 31, ob = rr * 64 + cc * 2; return st * 1024 + (ob ^ (((ob >> 9) & 1) << 5)); }
__host__ __device__ __forceinline__ void stage_rc(int b, int& R, int& C) { const int st = b / 1024, sb = b % 1024, swz = sb ^ (((sb >> 9) & 1) << 5); R = (st >> 1) * 16 + swz / 64; C = (st & 1) * 32 + (swz % 64) / 2; }
__host__ __device__ __forceinline__ int perm32(int rho) { const int n = rho >> 4, i = rho & 15; return 8 * (i >> 2) + 4 * n + (i & 3); }

struct GUnit { const char* A; const char* B; unsigned lda, ldb; int nt, mode; bf16* dst; int ldc; const bf16* aux; int ldaux; float scale; };
__device__ __forceinline__ void unit_order(int l, int nwg, int nM, int nN, int& pm, int& pn) {
    const int q = nwg / 8, xcd = l % 8, off = l / 8; const int wgid = xcd * q + off;
    const int nig = 8 * nN, gid = wgid / nig, fm = gid * 8, gsz = (nM - fm) < 8 ? (nM - fm) : 8;
    pm = fm + ((wgid % nig) % gsz); pn = (wgid % nig) / gsz;
}
__device__ __forceinline__ bool gemm_next(const Args& P, int ph, int hf, int i, int c, int G, GUnit& u) {
    unsigned char* ws = P.ws; const char* WT = (const char*)(ws + WS_WT); const char* XN = (const char*)(ws + WS_XN) + (size_t)hf * HTOK * 2048;
    unsigned char* R = ws + WS_R;
    u.aux = nullptr; u.ldaux = 0; u.scale = 1.f; u.mode = 0; u.lda = 2048; u.ldb = 2048; u.nt = 16;
    const int L = i * G + c;
    if (ph == 1) {
        if (L >= 1280) return false;
        if (L < 896) { int pm, pn; unit_order(L, 896, 64, 14, pm, pn);
            u.A = XN + (size_t)pm * 256 * 2048; u.B = WT + (size_t)pn * 256 * 2048;
            if (pn < 12) { u.dst = (bf16*)(R + R_QK) + (size_t)pm * 256 * 3072 + pn * 256; u.ldc = 3072; u.scale = ((pn & 3) < 2) ? 0.125f : 1.f; }
            else { u.dst = (bf16*)(R + R_GA) + (size_t)pm * 256 * 512 + (pn - 12) * 256; u.ldc = 512; u.mode = 1; }
        } else { int l = L - 896; const int g = l / 128; l -= g * 128; int pm, pn; unit_order(l, 128, 2, 64, pm, pn);
            const int r = (g == 0) ? 1 : (g == 1 ? 4 : 16), S = hf ? 4096 : 8192, tps = S / 256, seq = pn / tps, tq = (pn % tps) * 256, lr = S / r, cc = tq / lr, i0 = tq % lr;
            u.A = WT + (size_t)(3584 + g * 512 + pm * 256) * 2048;
            u.B = XN + (size_t)(seq * S + i0 * r + cc) * 2048; u.ldb = 2048u * r;
            u.dst = (bf16*)(R + R_VT) + (size_t)(g * 512 + pm * 256) * HTOK + pn * 256; u.ldc = HTOK; }
        return true;
    }
    if (ph == 3) {
        if (L >= 1024) return false; int pm, pn; unit_order(L, 1024, 16, 64, pm, pn);
        u.A = WT + (size_t)(5120 + pm * 256) * 2048; u.B = XN + (size_t)pn * 256 * 2048; u.ldc = HTOK;
        if (pm < 12) u.dst = (bf16*)(R + R_U) + (size_t)pm * 256 * HTOK + pn * 256;
        else { u.dst = (bf16*)(R + R_HS) + (size_t)(pm - 12) * 256 * HTOK + pn * 256; u.mode = 1; }
        return true;
    }
    if (ph == 6) {
        const int tile = c + (i >> 2) * G, sub = i & 3; if (tile >= 256) return false;
        const int pm = tile >> 2, pn = tile & 3;
        bf16* MGS = (bf16*)(R + R_MGS) + (size_t)pm * 256 * 2048 + pn * 256; bf16* MRG = (bf16*)(R + R_MRG) + (size_t)pm * 256 * 1024 + pn * 256;
        const char* OS = (const char*)P.out + (size_t)hf * 64 * MiB;
        if (sub < 2) { u.A = XN + (size_t)pm * 256 * 2048; u.B = WT + (size_t)(9216 + sub * 1024 + pn * 256) * 2048; u.dst = MGS + sub * 1024; u.ldc = 2048; u.mode = 2; }
        else if (sub == 2) { u.A = OS + O_AS + (size_t)pm * 256 * 1024; u.lda = 1024; u.B = (const char*)(ws + WS_WBA) + (size_t)pn * 256 * 1024; u.ldb = 1024; u.nt = 8;
            u.dst = MRG; u.ldc = 1024; u.aux = MGS; u.ldaux = 2048; u.mode = 3; }
        else { u.A = (const char*)(R + R_HS) + (size_t)pm * 256 * 2048; u.B = (const char*)(ws + WS_WBH) + (size_t)pn * 256 * 2048; u.dst = MRG; u.ldc = 1024; u.aux = MGS + 1024; u.ldaux = 2048; u.mode = 4; }
        return true;
    }
    if (L >= 256) return false;
    { int pm, pn; unit_order(L, 256, 64, 4, pm, pn);
      u.A = (const char*)(R + R_MRG) + (size_t)pm * 256 * 2048; u.B = (const char*)(ws + WS_WO) + (size_t)pn * 256 * 2048;
      u.dst = (bf16*)(R + R_OUT) + (size_t)pm * 256 * 1024 + pn * 256; u.ldc = 1024; }
    return true;
}

__device__ __forceinline__ void gemm_epi(const f32x4 (&acc)[2][2][4][2], const GUnit& u, int wr, int wc, int fr, int fq) {
    const int row0 = wr * 64 + fr, col0 = wc * 32 + 8 * fq;
#pragma unroll
    for (int ai = 0; ai < 2; ++ai)
#pragma unroll
        for (int m = 0; m < 4; ++m) {
            const int row = row0 + ai * HALF + m * 16;
            bf16* rowp = u.dst + (size_t)row * u.ldc + col0;
#pragma unroll
            for (int bj = 0; bj < 2; ++bj) {
                f32x4 v0 = acc[ai][bj][m][0], v1 = acc[ai][bj][m][1];
                float v[8] = {v0[0], v0[1], v0[2], v0[3], v1[0], v1[1], v1[2], v1[3]};
                if (u.mode == 0) {
#pragma unroll
                    for (int e = 0; e < 8; ++e) v[e] *= u.scale;
                } else if (u.mode == 1) {
#pragma unroll
                    for (int e = 0; e < 8; ++e) v[e] = v[e] * sigmoidf_(v[e]);
                } else if (u.mode == 2) {
#pragma unroll
                    for (int e = 0; e < 8; ++e) v[e] = sigmoidf_(v[e]);
                } else {
                    const u32x4 gw = *(const u32x4*)(u.aux + (size_t)row * u.ldaux + col0 + bj * HALF);
                    float g[8] = {bflo(gw.x), bfhi(gw.x), bflo(gw.y), bfhi(gw.y), bflo(gw.z), bfhi(gw.z), bflo(gw.w), bfhi(gw.w)};
                    if (u.mode == 3) {
#pragma unroll
                        for (int e = 0; e < 8; ++e) v[e] = g[e] * v[e];
                    } else {
                        const u32x4 pw = *(const u32x4*)(rowp + bj * HALF);
                        float p[8] = {bflo(pw.x), bfhi(pw.x), bflo(pw.y), bfhi(pw.y), bflo(pw.z), bfhi(pw.z), bflo(pw.w), bfhi(pw.w)};
#pragma unroll
                        for (int e = 0; e < 8; ++e) v[e] = p[e] + g[e] * v[e];
                    }
                }
                u32x4 w; w.x = pk2(v[0], v[1]); w.y = pk2(v[2], v[3]); w.z = pk2(v[4], v[5]); w.w = pk2(v[6], v[7]);
                *(u32x4*)(rowp + bj * HALF) = w;
            }
        }
}

__device__ __forceinline__ void gemm_phase(LAS unsigned char* lds, const Args& P, int ph, int hf, int c, int G) {
    int tid = threadIdx.x; asm volatile("" : "+v"(tid));
    const int wid = __builtin_amdgcn_readfirstlane(tid >> 6), lane = tid & 63, wr = wid >> 2, wc = wid & 3, fr = lane & 15, fq = lane >> 4;
    const unsigned ldsw = (unsigned)wid * 1024u;
    const int aoff = lds_byte(wr * 64 + fr, fq * 8), boff = lds_byte(wc * 32 + fr, fq * 8);
#define PG8_SA(b, h) (((b) * 2 + (h)) * HTB)
#define PG8_SB(b, h) ((4 + (b) * 2 + (h)) * HTB)
#define PG8_STAGE(bufoff, gbase, ld, ISB) do { int _t = tid; asm volatile("" : "+v"(_t)); _Pragma("unroll") for (int _i = 0; _i < 2; ++_i) { int _R, _C; stage_rc(_t * 16 + _i * 8192, _R, _C); \
        if (ISB) _R = (_R & ~31) + perm32(_R & 31); \
        __builtin_amdgcn_global_load_lds((const unsigned*)((const char*)(gbase) + (size_t)((unsigned)_R * (ld) + (unsigned)(_C * 2))), (LAS unsigned*)(lds + (bufoff) + ldsw + _i * 8192), 16, 0, 0); } } while (0)
#define RA 0
#define RB 1
#define PG8_LDA(dst, b, h) do { _Pragma("unroll") for (int m = 0; m < 4; ++m) _Pragma("unroll") for (int k = 0; k < 2; ++k) dst[m][k] = *(const LAS bf16x8*)(lds + PG8_SA(b, h) + aoff + m * 2048 + k * 1024); } while (0)
#define PG8_LDB(dst, b, h) do { _Pragma("unroll") for (int n = 0; n < 2; ++n) _Pragma("unroll") for (int k = 0; k < 2; ++k) dst[n][k] = *(const LAS bf16x8*)(lds + PG8_SB(b, h) + boff + n * 2048 + k * 1024); } while (0)
#define PG8_MMA(ai, bj, At, Bt) do { __builtin_amdgcn_s_setprio(1); _Pragma("unroll") for (int m = 0; m < 4; ++m) _Pragma("unroll") for (int n = 0; n < 2; ++n) _Pragma("unroll") for (int k = 0; k < 2; ++k) \
        acc[ai][bj][m][n] = __builtin_amdgcn_mfma_f32_16x16x32_bf16(Bt[n][k], At[m][k], acc[ai][bj][m][n], 0, 0, 0); __builtin_amdgcn_s_setprio(0); } while (0)
#define PG8_WAIT_V(n) asm volatile("s_waitcnt vmcnt(" #n ")" ::: "memory")
#define PG8_WAIT_L(n) asm volatile("s_waitcnt lgkmcnt(" #n ")" ::: "memory")
#define PG8_BAR __builtin_amdgcn_s_barrier()
#define PG8_SCHED __builtin_amdgcn_sched_barrier(0)
    int ui = 0;
    const char* cA; const char* cB; unsigned clda, cldb; int nt;
    { GUnit u0; if (!gemm_next(P, ph, hf, 0, c, G, u0)) return; cA = u0.A; cB = u0.B; clda = u0.lda; cldb = u0.ldb; nt = u0.nt; }
    f32x4 acc[2][2][4][2];
#pragma unroll
    for (int a = 0; a < 2; ++a)
#pragma unroll
        for (int b = 0; b < 2; ++b)
#pragma unroll
            for (int m = 0; m < 4; ++m)
#pragma unroll
                for (int n = 0; n < 2; ++n) acc[a][b][m][n] = (f32x4){0.f, 0.f, 0.f, 0.f};
    bf16x8 At[4][2], B0[2][2], B1[2][2];
    const size_t kstep = 128;
    {
        const size_t hA = (size_t)HALF * clda, hB = (size_t)HALF * cldb;
        PG8_STAGE(PG8_SB(0, 0), cB, cldb, RB); PG8_STAGE(PG8_SB(0, 1), cB + hB, cldb, RB); PG8_STAGE(PG8_SA(0, 0), cA, clda, RA); PG8_STAGE(PG8_SA(0, 1), cA + hA, clda, RA);
        if (wr == 1) PG8_BAR;
        PG8_WAIT_V(2); PG8_BAR;
        PG8_STAGE(PG8_SB(1, 0), cB + kstep, cldb, RB); PG8_STAGE(PG8_SA(1, 0), cA + kstep, clda, RA); PG8_STAGE(PG8_SB(1, 1), cB + hB + kstep, cldb, RB);
        PG8_WAIT_V(6); PG8_BAR;
    }
    for (;;) {
        bool has_next = false; const char* nA = cA; const char* nB = cB; unsigned nlda = clda, nldb = cldb; int nnt = nt;
        const size_t hA = (size_t)HALF * clda;
        for (int t = 0; t < nt; t += 2) {
            const bool last = (t == nt - 2);
            if (last) { GUnit un; has_next = gemm_next(P, ph, hf, ui + 1, c, G, un); if (has_next) { nA = un.A; nB = un.B; nlda = un.lda; nldb = un.ldb; nnt = un.nt; } }
            const char* a1 = cA + (size_t)(t + 1) * kstep;
            const char* a2 = last ? nA : cA + (size_t)(t + 2) * kstep; const char* b2 = last ? nB : cB + (size_t)(t + 2) * kstep;
            const unsigned lda2 = last ? nlda : clda, ldb2 = last ? nldb : cldb; const size_t hA2 = (size_t)HALF * lda2, hB2 = (size_t)HALF * ldb2;
            const char* a3 = a2 + kstep; const char* b3 = b2 + kstep;
            PG8_LDB(B0, 0, 0); PG8_LDB(B1, 0, 1); PG8_SCHED; PG8_LDA(At, 0, 0); PG8_STAGE(PG8_SA(1, 1), a1 + hA, clda, RA);
            PG8_WAIT_V(8); PG8_WAIT_L(0); PG8_BAR; PG8_MMA(0, 0, At, B0); PG8_MMA(0, 1, At, B1); PG8_BAR; PG8_SCHED;
            PG8_LDA(At, 0, 1); PG8_STAGE(PG8_SB(0, 0), b2, ldb2, RB); PG8_STAGE(PG8_SB(0, 1), b2 + hB2, ldb2, RB); PG8_STAGE(PG8_SA(0, 0), a2, lda2, RA);
            PG8_WAIT_V(8); PG8_WAIT_L(0); PG8_BAR; PG8_MMA(1, 0, At, B0); PG8_MMA(1, 1, At, B1); PG8_BAR; PG8_SCHED;
            PG8_LDB(B0, 1, 0); PG8_LDB(B1, 1, 1); PG8_SCHED; PG8_LDA(At, 1, 0); PG8_STAGE(PG8_SA(0, 1), a2 + hA2, lda2, RA);
            PG8_WAIT_V(8); PG8_WAIT_L(0); PG8_BAR; PG8_MMA(0, 0, At, B0); PG8_MMA(0, 1, At, B1); PG8_BAR; PG8_SCHED;
            PG8_LDA(At, 1, 1); PG8_STAGE(PG8_SB(1, 0), b3, ldb2, RB); PG8_STAGE(PG8_SB(1, 1), b3 + hB2, ldb2, RB); PG8_STAGE(PG8_SA(1, 0), a3, lda2, RA);
            PG8_WAIT_V(8); PG8_WAIT_L(0); PG8_BAR; PG8_MMA(1, 0, At, B0); PG8_MMA(1, 1, At, B1); PG8_BAR; PG8_SCHED;
        }
        if (wr == 0) PG8_BAR;
        { GUnit ue; (void)gemm_next(P, ph, hf, ui, c, G, ue); gemm_epi(acc, ue, wr, wc, fr, fq); }
        if (!has_next) break;
#pragma unroll
        for (int a = 0; a < 2; ++a)
#pragma unroll
            for (int b = 0; b < 2; ++b)
#pragma unroll
                for (int m = 0; m < 4; ++m)
#pragma unroll
                    for (int n = 0; n < 2; ++n) acc[a][b][m][n] = (f32x4){0.f, 0.f, 0.f, 0.f};
        cA = nA; cB = nB; clda = nlda; cldb = nldb; nt = nnt; ++ui;
        if (wr == 1) PG8_BAR;
    }
    PG8_WAIT_V(0);
    PG8_BAR;
#undef PG8_SA
#undef PG8_SB
#undef PG8_STAGE
#undef RA
#undef RB
#undef PG8_LDA
#undef PG8_LDB
#undef PG8_MMA
#undef PG8_WAIT_V
#undef PG8_WAIT_L
#undef PG8_BAR
#undef PG8_SCHED
}
}

__device__ __forceinline__ void p0_transpose_item(const float* W, int ldw, int c0, int ncols, int K, bf16* WT, int row_off, LAS float* scr, int item, int lane) {
    const int nblk = ncols / 32, kb = item / nblk, nb = item % nblk, k0 = 64 * kb, n0 = 32 * nb;
#pragma unroll 8
    for (int i = 0; i < 32; ++i) { const int kk = 2 * i + (lane >> 5); scr[kk * 33 + (lane & 31)] = W[(size_t)(k0 + kk) * ldw + c0 + n0 + (lane & 31)]; }
    LDS_WAIT(); asm volatile("" ::: "memory");
    const int c = lane & 7;
#pragma unroll
    for (int j = 0; j < 4; ++j) { const int n = (lane >> 3) + 8 * j; const LAS float* s = scr + (8 * c) * 33 + n;
        u32x4 o; o.x = pk2(s[0 * 33], s[1 * 33]); o.y = pk2(s[2 * 33], s[3 * 33]); o.z = pk2(s[4 * 33], s[5 * 33]); o.w = pk2(s[6 * 33], s[7 * 33]);
        *(u32x4*)(WT + (size_t)(row_off + n0 + n) * K + k0 + 8 * c) = o; }
    LDS_WAIT(); asm volatile("" ::: "memory");
}
__device__ __forceinline__ float rdlane(float v, int l) { return __builtin_bit_cast(float, __builtin_amdgcn_readlane(__builtin_bit_cast(int, v), l)); }

__device__ __forceinline__ void p0_prologue(const Args& P, LAS unsigned char* lds, int vcu, int G, int wave, int lane) {
    LAS float* scr = (LAS float*)(lds + wave * 16384);
    const int gw = vcu * NWAVES + wave, NGW = G * NWAVES;
    unsigned char* ws = P.ws;
    constexpr int IT_BLK = 16 * 16;
    constexpr int NIT = 22 * IT_BLK + (512 / 64) * (1024 / 32) + 2 * (1024 / 64) * (1024 / 32);
    for (int it = gw; it < NIT; it += NGW) {
        int r = it;
        if (r < 22 * IT_BLK) { const int b = r / IT_BLK; r -= b * IT_BLK;
            const int src = (b == 0) ? 0 : (b == 1) ? 3 : (b == 2) ? 1 : (b == 3) ? 4 : (b == 4) ? 2 : (b == 5) ? 5 : (b == 6) ? 9 : (b == 7) ? 6 : (b == 8) ? 7 : (b == 9) ? 8 : b;
            p0_transpose_item(P.w_in, 11264, src * 512, 512, 1024, (bf16*)(ws + WS_WT), b * 512, scr, r, lane); continue; }
        r -= 22 * IT_BLK;
        if (r < 256) { p0_transpose_item(P.wba, 1024, 0, 1024, 512, (bf16*)(ws + WS_WBA), 0, scr, r, lane); continue; }
        r -= 256;
        if (r < 512) { p0_transpose_item(P.wbh, 1024, 0, 1024, 1024, (bf16*)(ws + WS_WBH), 0, scr, r, lane); continue; }
        r -= 512;
        p0_transpose_item(P.wout, 1024, 0, 1024, 1024, (bf16*)(ws + WS_WO), 0, scr, r, lane);
    }
    {
        f32x4 g4[4];
#pragma unroll
        for (int j = 0; j < 4; ++j) g4[j] = ((const f32x4*)P.pre_g)[lane + 64 * j];
        for (int m = gw; m < MTOK; m += NGW) {
            const float* xrow = (m < HTOK) ? P.xp + (size_t)m * DM : P.xs + (size_t)(m - HTOK) * DM;
            const f32x4* xr = (const f32x4*)xrow + lane;
            f32x4 v[4]; float s = 0.f;
#pragma unroll
            for (int j = 0; j < 4; ++j) { v[j] = xr[64 * j]; s += (v[j].x * v[j].x + v[j].y * v[j].y) + (v[j].z * v[j].z + v[j].w * v[j].w); }
            const float rstd = 1.0f / sqrtf(wave_sum(s) * (1.f / DM) + EPS);
            unsigned long long* o8 = (unsigned long long*)((bf16*)(ws + WS_XN) + (size_t)m * DM) + lane;
#pragma unroll
            for (int j = 0; j < 4; ++j) o8[64 * j] = (unsigned long long)pk2(v[j].x * rstd * g4[j].x, v[j].y * rstd * g4[j].y) | ((unsigned long long)pk2(v[j].z * rstd * g4[j].z, v[j].w * rstd * g4[j].w) << 32);
        }
    }
    {
        const float fr = P.ffreq[lane], b1 = P.fb1[lane], b2 = P.fb2[lane], b3 = P.fb3[lane];
        for (int row = gw; row < 12288; row += NGW) {
            const int Lf = (row < 8192) ? 8192 : 4096, t = (row < 8192) ? row : row - 8192;
            const float tt = (float)t * (1.0f / (float)(Lf - 1));
            const float ang = (6.283185307179586f / (float)Lf) * (float)t;
            const int k = (lane >= 17) ? lane - 17 : lane - 1;
            const float band = 1e-4f + (float)(k & 15) * ((15.0f - 1e-4f) / 15.0f);
            const float a = ang * band;
            float z = (lane == 0) ? tt : ((lane <= 16) ? cosf(a) : -sinf(a));
            float acc = b1;
#pragma unroll
            for (int i = 0; i < 33; ++i) acc += rdlane(z, i) * P.fw1[i * 64 + lane];
            float h = sinf(fr * acc);
            acc = b2;
#pragma unroll 16
            for (int i = 0; i < 64; ++i) acc += rdlane(h, i) * P.fw2[i * 64 + lane];
            h = sinf(fr * acc);
            acc = b3;
#pragma unroll 16
            for (int i = 0; i < 64; ++i) acc += rdlane(h, i) * P.fw3[i * 64 + lane];
            h = sinf(fr * acc);
            { const unsigned hi = f2bf(h); const float lo = h - bf2f(hi);
              ((bf16*)(ws + WS_HDN))[(size_t)row * 64 + lane] = (bf16)hi; ((bf16*)(ws + WS_HDN) + (size_t)12288 * 64)[(size_t)row * 64 + lane] = (bf16)f2bf(lo); }
        }
    }
    {
        float* BT = (float*)(ws + WS_BT);
        for (int e = gw * 64 + lane; e < 3 * 8 * 129; e += NGW * 64) {
            const int g = e / (8 * 129), h = (e / 129) % 8, dd = e % 129;
            const int r = (g == 0) ? 1 : (g == 1 ? 4 : 16);
            const int rel = (dd - 64) * r; const int n = rel < 0 ? -rel : rel;
            const float nf = (float)(n > 1 ? n : 1);
            int large = 8 + (int)(logf(nf / 8.0f) / 4.852030263919617f * 8.0f);
            large = large < 15 ? large : 15;
            const int bucket = (rel > 0 ? 16 : 0) + (n < 8 ? n : large);
            BT[e] = P.rel_bias[bucket * 24 + g * 8 + h];
        }
    }
}

constexpr int AT_OB = 0, AT_LSE = 98304, AT_BT = 98304 + 3072;
__device__ __forceinline__ void attn_unit(const Args& P, LAS unsigned char* lds, int hf, int ch, int h, int tid, int wave, int lane) {
    const int S = hf ? 4096 : 8192, tps = S / 256, seq = ch / tps, T0 = (ch % tps) * 256, hs = seq * S;
    unsigned char* R = P.ws + WS_R;
    const bf16* QK = (const bf16*)(R + R_QK); const bf16* VT = (const bf16*)(R + R_VT); const bf16* GA = (const bf16*)(R + R_GA);
    bf16* AS = (bf16*)((unsigned char*)P.out + (size_t)hf * 64 * MiB + O_AS);
    LAS float* BTL = (LAS float*)(lds + AT_BT); LAS float* LSE = (LAS float*)(lds + AT_LSE);
    const float* BT = (const float*)(P.ws + WS_BT);
    if (tid < 3 * 129) { const int g = tid / 129, dd = tid % 129; BTL[g * 132 + dd] = BT[(g * 8 + h) * 129 + dd]; }
    __syncthreads();
    const int a = lane & 15, gq = lane >> 4;
    for (int wt = wave; wt < 48; wt += 8) {
        const int g = wt >> 4, j = wt & 15;
        const int r = (g == 0) ? 1 : (g == 1 ? 4 : 16);
        const int c = (g == 0) ? 0 : (g == 1 ? (j & 3) : j);
        const int i0 = (g == 0) ? (T0 + 16 * j) : (g == 1 ? (T0 / 4 + 16 * (j >> 2)) : (T0 / 16));
        const int lr = S / r;
        const bf16* qk_g = QK + g * 1024 + h * 64 + 8 * gq;
        const bf16* qp = qk_g + (size_t)(hs + (i0 + a) * r + c) * 3072;
        const bf16x8 q0 = *(const bf16x8*)qp, q1 = *(const bf16x8*)(qp + 32);
        f32x4 s[9];
#pragma unroll
        for (int kt = 0; kt < 9; ++kt) {
            int ki = i0 - 64 + 16 * kt + a; ki = ki < 0 ? 0 : (ki > lr - 1 ? lr - 1 : ki);
            const bf16* kp = qk_g + 512 + (size_t)(hs + ki * r + c) * 3072;
            const bf16x8 k0 = *(const bf16x8*)kp, k1 = *(const bf16x8*)(kp + 32);
            f32x4 z = {0.f, 0.f, 0.f, 0.f};
            z = __builtin_amdgcn_mfma_f32_16x16x32_bf16(k0, q0, z, 0, 0, 0);
            s[kt] = __builtin_amdgcn_mfma_f32_16x16x32_bf16(k1, q1, z, 0, 0, 0);
        }
        float mx = -1e30f;
#pragma unroll
        for (int kt = 0; kt < 9; ++kt)
#pragma unroll
            for (int rg = 0; rg < 4; ++rg) {
                const int kk = 16 * kt + 4 * gq + rg, dd = kk - a, ki = i0 - 64 + kk;
                const bool ok = (dd >= 0) && (dd <= 128) && (ki >= 0) && (ki < lr);
                const float v = ok ? s[kt][rg] + BTL[g * 132 + (dd < 0 ? 0 : (dd > 128 ? 128 : dd))] : -1e30f;
                s[kt][rg] = v; mx = fmaxf(mx, v);
            }
        mx = fmaxf(mx, __shfl_xor(mx, 16)); mx = fmaxf(mx, __shfl_xor(mx, 32));
        float ls = 0.f;
#pragma unroll
        for (int kt = 0; kt < 9; ++kt)
#pragma unroll
            for (int rg = 0; rg < 4; ++rg) { const float p = __expf(s[kt][rg] - mx); s[kt][rg] = p; ls += p; }
        ls += __shfl_xor(ls, 16); ls += __shfl_xor(ls, 32);
        f32x4 o[4];
#pragma unroll
        for (int dt = 0; dt < 4; ++dt) o[dt] = (f32x4){0.f, 0.f, 0.f, 0.f};
        const bf16* vt_g = VT + (size_t)(g * 512 + h * 64 + a) * HTOK + hs + c * lr;
#pragma unroll
        for (int pp = 0; pp < 5; ++pp) {
            const int kt0 = 2 * pp, kt1 = 2 * pp + 1;
            bf16x8 pf;
            { const unsigned w0 = pk2(s[kt0][0], s[kt0][1]), w1 = pk2(s[kt0][2], s[kt0][3]);
              unsigned w2 = 0u, w3 = 0u; if (kt1 < 9) { w2 = pk2(s[kt1 < 9 ? kt1 : 8][0], s[kt1 < 9 ? kt1 : 8][1]); w3 = pk2(s[kt1 < 9 ? kt1 : 8][2], s[kt1 < 9 ? kt1 : 8][3]); }
              const u32x4 pw = {w0, w1, w2, w3}; pf = __builtin_bit_cast(bf16x8, pw); }
            int ks0 = i0 - 64 + 16 * kt0 + 4 * gq; ks0 = ks0 < 0 ? 0 : (ks0 > lr - 4 ? lr - 4 : ks0);
            int ks1 = i0 - 64 + 16 * kt1 + 4 * gq; ks1 = ks1 < 0 ? 0 : (ks1 > lr - 4 ? lr - 4 : ks1);
#pragma unroll
            for (int dt = 0; dt < 4; ++dt) {
                const bf16* vp = vt_g + (size_t)(16 * dt) * HTOK;
                const u32x2 va = *(const u32x2*)(vp + ks0);
                u32x2 vb = {0u, 0u}; if (kt1 < 9) vb = *(const u32x2*)(vp + ks1);
                const u32x4 vw = {va.x, va.y, vb.x, vb.y};
                o[dt] = __builtin_amdgcn_mfma_f32_16x16x32_bf16(__builtin_bit_cast(bf16x8, vw), pf, o[dt], 0, 0, 0);
            }
        }
        const float inv = 1.0f / ls;
        const int tl = (i0 + a) * r + c - T0;
#pragma unroll
        for (int dt = 0; dt < 4; ++dt) {
            const u32x2 w = {pk2(o[dt][0] * inv, o[dt][1] * inv), pk2(o[dt][2] * inv, o[dt][3] * inv)};
            *(LAS u32x2*)(lds + AT_OB + ((g * 256 + tl) * 64 + 16 * dt + 4 * gq) * 2) = w;
        }
        if (gq == 0) LSE[g * 256 + tl] = mx + __logf(ls);
    }
    __syncthreads();
    for (int it = tid; it < 2048; it += NTHREADS) {
        const int tl = it >> 3, ck = it & 7;
        const float l0 = LSE[tl], l1 = LSE[256 + tl], l2 = LSE[512 + tl];
        const float m = fmaxf(l0, fmaxf(l1, l2));
        float w0 = __expf(l0 - m), w1 = __expf(l1 - m), w2 = __expf(l2 - m);
        const float iw = 1.0f / (w0 + w1 + w2); w0 *= iw; w1 *= iw; w2 *= iw;
        const u32x4 a0 = *(const LAS u32x4*)(lds + AT_OB + ((0 * 256 + tl) * 64 + 8 * ck) * 2);
        const u32x4 a1 = *(const LAS u32x4*)(lds + AT_OB + ((1 * 256 + tl) * 64 + 8 * ck) * 2);
        const u32x4 a2 = *(const LAS u32x4*)(lds + AT_OB + ((2 * 256 + tl) * 64 + 8 * ck) * 2);
        const size_t row = (size_t)(hs + T0 + tl);
        const u32x4 gv = *(const u32x4*)(GA + row * 512 + h * 64 + 8 * ck);
        u32x4 ov;
#define AT_MIX(F) pk2((w0 * bflo(a0.F) + w1 * bflo(a1.F) + w2 * bflo(a2.F)) * bflo(gv.F), (w0 * bfhi(a0.F) + w1 * bfhi(a1.F) + w2 * bfhi(a2.F)) * bfhi(gv.F))
        ov.x = AT_MIX(x); ov.y = AT_MIX(y); ov.z = AT_MIX(z); ov.w = AT_MIX(w);
#undef AT_MIX
        *(u32x4*)(AS + row * 512 + h * 64 + 8 * ck) = ov;
    }
    __syncthreads();
}

__device__ __forceinline__ void fft16k(LAS FC* Dd, int log2n, int tid) {
    FC v[32];
    fft_pass_load<16>(Dd, log2n, 0, tid, v); __syncthreads(); fft_pass_store<16>(Dd, log2n, 0, tid, v); __syncthreads();
    fft_pass_load<16>(Dd, log2n, 4, tid, v); __syncthreads(); fft_pass_store<16>(Dd, log2n, 4, tid, v); __syncthreads();
    fft_pass_load<16>(Dd, log2n, 8, tid, v); __syncthreads(); fft_pass_store<16>(Dd, log2n, 8, tid, v); __syncthreads();
    if (log2n == 14) { fft_pass_load<4>(Dd, log2n, 12, tid, v); __syncthreads(); fft_pass_store<4>(Dd, log2n, 12, tid, v); __syncthreads(); }
    else             { fft_pass_load<2>(Dd, log2n, 12, tid, v); __syncthreads(); fft_pass_store<2>(Dd, log2n, 12, tid, v); __syncthreads(); }
}
struct SC2 { unsigned wp, wc, wn; };
__device__ __forceinline__ SC2 sc_load(const bf16* row, int t, int Ls) {
    SC2 s; const unsigned* p = (const unsigned*)(row + t);
    s.wc = p[0]; s.wp = (t >= 2) ? p[-1] : 0u; s.wn = (t + 2 < Ls) ? p[1] : 0u; return s;
}
__device__ __forceinline__ FC sc_eval(const SC2& s, float w0, float w1, float w2, float b) {
    const float um = bfhi(s.wp), u0 = bflo(s.wc), u1 = bfhi(s.wc), u2 = bflo(s.wn);
    FC r; r.x = um * w0 + u0 * w1 + u1 * w2 + b; r.y = u0 * w0 + u1 * w1 + u2 * w2 + b; return r;
}
__device__ __forceinline__ void hyena_unit(const Args& P, LAS unsigned char* lds, int hf, int c, int tid) {
    const int Ls = hf ? 4096 : 8192, log2n = hf ? 13 : 14, N = 2 * Ls;
    LAS FC* Dd = (LAS FC*)lds;
    LAS float* Df = (LAS float*)lds;
    unsigned char* R = P.ws + WS_R;
    const bf16* U = (const bf16*)(R + R_U); const bf16* GH = (const bf16*)(R + R_HS); bf16* HS2 = (bf16*)((unsigned char*)P.out + (size_t)hf * 64 * MiB + O_HST);
    FC* Xs = (FC*)(R + R_XS) + (size_t)blockIdx.x * 16384;
    FC* ZZ = (FC*)((unsigned char*)P.out + (size_t)hf * 64 * MiB + O_ZZ) + (size_t)blockIdx.x * 8192;
    const bf16* HDH = (const bf16*)(P.ws + WS_HDN) + (hf ? (size_t)8192 * 64 : 0); const bf16* HDL = HDH + (size_t)12288 * 64;
    asm volatile("" : "+v"(tid));
    {
        const int lane = tid & 63, wave = __builtin_amdgcn_readfirstlane(tid >> 6), col = lane & 15, kq = lane >> 4;
        if (tid == 0) { FC z = {0.f, 0.f}; Dd[fft_swz(Ls)] = z; }
        if (hf) for (int e = tid; e < 8192; e += NTHREADS) { FC z = {0.f, 0.f}; Dd[fft_swz(8192 + e)] = z; }
        bf16x8 Bh[2], Bl[2];
#pragma unroll
        for (int s = 0; s < 2; ++s) { unsigned hw[4], lw[4];
#pragma unroll
            for (int i2 = 0; i2 < 4; ++i2) { float w[2];
#pragma unroll
                for (int e = 0; e < 2; ++e) { const int j = 32 * s + 8 * kq + 2 * i2 + e; w[e] = (col < 4) ? P.fw4[(size_t)j * 4096 + col * 1024 + c] : 0.f; }
                const unsigned h0 = f2bf(w[0]), h1 = f2bf(w[1]); hw[i2] = h0 | (h1 << 16); lw[i2] = pk2(w[0] - bf2f(h0), w[1] - bf2f(h1)); }
            const u32x4 hv = {hw[0], hw[1], hw[2], hw[3]}, lv = {lw[0], lw[1], lw[2], lw[3]};
            Bh[s] = __builtin_bit_cast(bf16x8, hv); Bl[s] = __builtin_bit_cast(bf16x8, lv); }
        const float delta = fabsf(-3.0701134573253945f + (float)c * ((-15.350567286626973f + 3.0701134573253945f) / 1023.0f));
        const float tsc = -delta * (1.0f / (float)(Ls - 1));
        const int ntile = Ls / 16;
#pragma unroll 2
        for (int tile = wave; tile < ntile; tile += NWAVES) {
            const int t0 = tile * 16;
            const bf16* ah = HDH + (size_t)(t0 + col) * 64 + 8 * kq; const bf16* al = HDL + (size_t)(t0 + col) * 64 + 8 * kq;
            const bf16x8 ah0 = *(const bf16x8*)ah, ah1 = *(const bf16x8*)(ah + 32), al0 = *(const bf16x8*)al, al1 = *(const bf16x8*)(al + 32);
            f32x4 d = {0.f, 0.f, 0.f, 0.f};
            d = __builtin_amdgcn_mfma_f32_16x16x32_bf16(ah0, Bh[0], d, 0, 0, 0);
            d = __builtin_amdgcn_mfma_f32_16x16x32_bf16(ah1, Bh[1], d, 0, 0, 0);
            d = __builtin_amdgcn_mfma_f32_16x16x32_bf16(al0, Bh[0], d, 0, 0, 0);
            d = __builtin_amdgcn_mfma_f32_16x16x32_bf16(al1, Bh[1], d, 0, 0, 0);
            d = __builtin_amdgcn_mfma_f32_16x16x32_bf16(ah0, Bl[0], d, 0, 0, 0);
            d = __builtin_amdgcn_mfma_f32_16x16x32_bf16(ah1, Bl[1], d, 0, 0, 0);
            if (col < 4) {
#pragma unroll
                for (int rg = 0; rg < 4; ++rg) { const int t = t0 + 4 * kq + rg;
                    const float val = d[rg] * __expf((float)t * tsc);
                    const int idx = (col & 1) ? (N - t) : t;
                    if (!((col & 1) && t == 0)) Df[2 * fft_swz(idx) + (col >> 1)] = val; }
            }
        }
    }
    __syncthreads();
    fft16k(Dd, log2n, tid);
    asm volatile("" : "+v"(tid));
#pragma unroll 8
    for (int f = tid; f < N; f += NTHREADS) Xs[f] = Dd[fft_swz(f)];
    __syncthreads();
    const float* cw = P.conv_w; const float* cb = P.conv_b;
    const float wv0 = cw[c], wv1 = cw[3072 + c], wv2 = cw[6144 + c], bv = cb[c];
    const float wa0 = cw[1024 + c], wa1 = cw[3072 + 1024 + c], wa2 = cw[6144 + 1024 + c], ba = cb[1024 + c];
    const float wb0 = cw[2048 + c], wb1 = cw[3072 + 2048 + c], wb2 = cw[6144 + 2048 + c], bb = cb[2048 + c];
    const float sk1 = P.skip[c], sk2 = P.skip[1024 + c];
    const bf16* Uv = U + (size_t)c * HTOK; const bf16* Ua = U + (size_t)(1024 + c) * HTOK; const bf16* Ub = U + (size_t)(2048 + c) * HTOK;
    const bf16* Gc = GH + (size_t)c * HTOK; bf16* Hc = HS2 + (size_t)c * HTOK;
    const float invN = 1.0f / (float)N;
    const FC zero = {0.f, 0.f};
    asm volatile("" : "+v"(tid));
#pragma unroll 4
    for (int k = 0; k < 8; ++k) { const int e = 2 * (tid + 512 * k), bp = e / Ls, t = e - bp * Ls;
        const SC2 s0 = sc_load(Uv + (size_t)(2 * bp) * Ls, t, Ls), s1 = sc_load(Uv + (size_t)(2 * bp + 1) * Ls, t, Ls);
        const FC z0 = sc_eval(s0, wv0, wv1, wv2, bv), z1 = sc_eval(s1, wv0, wv1, wv2, bv);
        const int ix = bp * N + t;
        FC a = {z0.x, z1.x}, b = {z0.y, z1.y};
        Dd[fft_swz(ix)] = a; Dd[fft_swz(ix + 1)] = b; Dd[fft_swz(ix + Ls)] = zero; Dd[fft_swz(ix + Ls + 1)] = zero; }
    __syncthreads();
#pragma unroll 1
    for (int ord = 0; ord < 2; ++ord) {
        fft16k(Dd, log2n, tid);
        asm volatile("" : "+v"(tid));
#pragma unroll 8
        for (int idx = tid; idx < 16384; idx += NTHREADS) {
            const int f = idx & (N - 1);
            const FC x1 = Xs[f], x2 = Xs[(N - f) & (N - 1)];
            FC Kf;
            if (ord == 0) { Kf.x = 0.5f * (x1.x + x2.x); Kf.y = 0.5f * (x1.y - x2.y); }
            else { Kf.x = 0.5f * (x1.y + x2.y); Kf.y = -0.5f * (x1.x - x2.x); }
            Kf.x *= invN; Kf.y *= invN;
            const FC zv = Dd[fft_swz(idx)];
            FC y; y.x = zv.x * Kf.x - zv.y * Kf.y; y.y = -(zv.x * Kf.y + zv.y * Kf.x);
            Dd[fft_swz(idx)] = y;
        }
        __syncthreads();
        fft16k(Dd, log2n, tid);
        asm volatile("" : "+v"(tid));
        if (ord == 0) {
#pragma unroll 2
            for (int k = 0; k < 8; ++k) { const int e = 2 * (tid + 512 * k), bp = e / Ls, t = e - bp * Ls;
                const size_t r0 = (size_t)(2 * bp) * Ls, r1 = (size_t)(2 * bp + 1) * Ls;
                const SC2 sv0 = sc_load(Uv + r0, t, Ls), sv1 = sc_load(Uv + r1, t, Ls), sa0 = sc_load(Ua + r0, t, Ls), sa1 = sc_load(Ua + r1, t, Ls);
                const int ix = bp * N + t;
                const FC ya = Dd[fft_swz(ix)], yb = Dd[fft_swz(ix + 1)];
                const FC z0 = sc_eval(sv0, wv0, wv1, wv2, bv), z1 = sc_eval(sv1, wv0, wv1, wv2, bv), x0 = sc_eval(sa0, wa0, wa1, wa2, ba), x1 = sc_eval(sa1, wa0, wa1, wa2, ba);
                FC qa, qb; qa.x = x0.x * (ya.x + sk1 * z0.x); qa.y = x1.x * (-ya.y + sk1 * z1.x); qb.x = x0.y * (yb.x + sk1 * z0.y); qb.y = x1.y * (-yb.y + sk1 * z1.y);
                const f32x4 zq = {qa.x, qa.y, qb.x, qb.y}; *(f32x4*)(ZZ + e) = zq;
                Dd[fft_swz(ix)] = qa; Dd[fft_swz(ix + 1)] = qb; Dd[fft_swz(ix + Ls)] = zero; Dd[fft_swz(ix + Ls + 1)] = zero; }
            __syncthreads();
        } else {
#pragma unroll 2
            for (int k = 0; k < 8; ++k) { const int e = 2 * (tid + 512 * k), bp = e / Ls, t = e - bp * Ls;
                const size_t r0 = (size_t)(2 * bp) * Ls, r1 = (size_t)(2 * bp + 1) * Ls;
                const SC2 sb0 = sc_load(Ub + r0, t, Ls), sb1 = sc_load(Ub + r1, t, Ls);
                const unsigned g0 = *(const unsigned*)(Gc + r0 + t), g1 = *(const unsigned*)(Gc + r1 + t);
                const f32x4 zq = *(const f32x4*)(ZZ + e);
                const int ix = bp * N + t;
                const FC ya = Dd[fft_swz(ix)], yb = Dd[fft_swz(ix + 1)];
                const FC x0 = sc_eval(sb0, wb0, wb1, wb2, bb), x1 = sc_eval(sb1, wb0, wb1, wb2, bb);
                const float h00 = x0.x * (ya.x + sk2 * zq[0]), h10 = x1.x * (-ya.y + sk2 * zq[1]), h01 = x0.y * (yb.x + sk2 * zq[2]), h11 = x1.y * (-yb.y + sk2 * zq[3]);
                *(unsigned*)(Hc + r0 + t) = pk2(h00 * bflo(g0), h01 * bfhi(g0)); *(unsigned*)(Hc + r1 + t) = pk2(h10 * bflo(g1), h11 * bfhi(g1)); }
            __syncthreads();
        }
    }
}

__device__ __forceinline__ void transpose_phase(const Args& P, LAS unsigned char* lds, int hf, int vcu, int G, int tid) {
    const bf16* HS = (const bf16*)((unsigned char*)P.out + (size_t)hf * 64 * MiB + O_HST);
    bf16* HST = (bf16*)(P.ws + WS_R + R_HS);
    LAS bf16* T = (LAS bf16*)lds;
    for (int tile = vcu; tile < 16 * 64; tile += G) {
        const int cb = tile >> 6, tb = tile & 63;
#pragma unroll
        for (int ps = 0; ps < 4; ++ps) { const int rw = (tid >> 5) + 16 * ps, pc = tid & 31;
            const u32x4 v = *(const u32x4*)(HS + (size_t)(cb * 64 + rw) * HTOK + tb * 256 + pc * 8);
            const unsigned w[4] = {v.x, v.y, v.z, v.w};
#pragma unroll
            for (int e = 0; e < 4; ++e) { T[(pc * 8 + 2 * e) * 72 + rw] = (bf16)(w[e] & 0xffffu); T[(pc * 8 + 2 * e + 1) * 72 + rw] = (bf16)(w[e] >> 16); } }
        __syncthreads();
#pragma unroll
        for (int ps = 0; ps < 4; ++ps) { const int it = tid + 512 * ps, tk = it >> 3, ck = it & 7;
            const u32x4 v = *(const LAS u32x4*)(T + tk * 72 + ck * 8);
            *(u32x4*)(HST + (size_t)(tb * 256 + tk) * 1024 + cb * 64 + ck * 8) = v; }
        __syncthreads();
    }
}

__device__ __forceinline__ void norm_phase(const Args& P, int hf, int vcu, int G, int wave, int lane) {
    const bf16* OUT = (const bf16*)(P.ws + WS_R + R_OUT);
    const float* x = hf ? P.xs : P.xp; float* y = P.out + (size_t)hf * HTOK * DM;
    const int gw = vcu * NWAVES + wave, NGW = G * NWAVES;
    f32x4 g4[4];
#pragma unroll
    for (int j = 0; j < 4; ++j) g4[j] = ((const f32x4*)P.post_g)[lane + 64 * j];
    for (int m = gw; m < HTOK; m += NGW) {
        const u32x2* orow = (const u32x2*)(OUT + (size_t)m * DM) + lane;
        f32x4 v[4]; float s = 0.f;
#pragma unroll
        for (int j = 0; j < 4; ++j) { const u32x2 w = orow[64 * j]; v[j] = (f32x4){bflo(w.x), bfhi(w.x), bflo(w.y), bfhi(w.y)}; s += (v[j].x * v[j].x + v[j].y * v[j].y) + (v[j].z * v[j].z + v[j].w * v[j].w); }
        const float rstd = 1.0f / sqrtf(wave_sum(s) * (1.f / DM) + EPS);
        const f32x4* xr = (const f32x4*)(x + (size_t)m * DM) + lane; f32x4* yr = (f32x4*)(y + (size_t)m * DM) + lane;
#pragma unroll
        for (int j = 0; j < 4; ++j) { const f32x4 xv = xr[64 * j]; yr[64 * j] = xv + v[j] * rstd * g4[j]; }
    }
}

__global__ void __launch_bounds__(NTHREADS, 2) mk_fwd(const Args P) {
    extern __shared__ __attribute__((aligned(16))) unsigned char lds_raw[];
    cg::grid_group grid = cg::this_grid();
    LAS unsigned char* lds = (LAS unsigned char*)lds_raw;
    volatile LAS unsigned* MISC = (volatile LAS unsigned*)(lds + MISC_OFF);
    const int tid = threadIdx.x, lane = tid & 63, wave = __builtin_amdgcn_readfirstlane(tid >> 6);
    const int G = gridDim.x, bx = blockIdx.x;
    const int vcu = (G % 8 == 0) ? (bx % 8) * (G / 8) + bx / 8 : bx;
    for (int u = tid; u < (LDS_BYTES - RING_BYTES) / 4; u += NTHREADS) ((LAS unsigned*)(lds + RING_BYTES))[u] = 0u;
    __syncthreads();
    XcdBarrier bar = xcd_barrier_post((unsigned*)(P.ws + WS_CTL) + 4096, MISC + 8);
#ifndef NO_P0
    p0_prologue(P, lds, vcu, G, wave, lane);
#ifdef REP_P0
    __syncthreads(); p0_prologue(P, lds, vcu, G, wave, lane);
#endif
#endif
    grid.sync();
    int rep = 0; (void)rep;
#pragma unroll 1
    for (int hf = 0; hf < 2; ++hf) {
#pragma unroll 1
        for (int ph = 1; ph <= 8; ++ph) {
            int tq = threadIdx.x; asm volatile("" : "+v"(tq));
            const int lq = tq & 63, wq = __builtin_amdgcn_readfirstlane(tq >> 6);
            if (ph == 1 || ph == 3 || ph == 6 || ph == 7) {
#ifndef NO_GEMM
                pg8::gemm_phase(lds, P, ph, hf, bx, G);
#endif
            } else if (ph == 2) {
#ifndef NO_ATTN
                for (int u = bx; u < 512; u += G) attn_unit(P, lds, hf, u >> 3, u & 7, tq, wq, lq);
#endif
            } else if (ph == 4) {
#ifndef NO_HY
                for (int c = bx; c < 1024; c += G) hyena_unit(P, lds, hf, c, tq);
#endif
            } else if (ph == 5) {
                transpose_phase(P, lds, hf, vcu, G, tq);
            } else {
                norm_phase(P, hf, vcu, G, wq, lq);
            }
            if (!(hf == 1 && ph == 8)) xcd_barrier(bar);
#ifdef REP_PH
            if (ph == REP_PH && rep == 0) { rep = 1; --ph; } else rep = 0;
#endif
        }
    }
}

extern "C" void kernel_launch(void* const* d_in, const int* in_sizes, int n_in, void* d_out, int out_size, void* d_ws, size_t ws_size, hipStream_t stream) {
    static int grid = 0;
    if (grid == 0) {
        int dev = 0, cus = 0, per_cu = 0;
        (void)hipGetDevice(&dev);
        (void)hipDeviceGetAttribute(&cus, hipDeviceAttributeMultiprocessorCount, dev);
        (void)hipFuncSetAttribute((const void*)mk_fwd, hipFuncAttributeMaxDynamicSharedMemorySize, LDS_BYTES);
        (void)hipOccupancyMaxActiveBlocksPerMultiprocessor(&per_cu, (const void*)mk_fwd, NTHREADS, LDS_BYTES);
        (void)hipGetLastError();
        grid = cus;
        if (per_cu < 1 || n_in != 20 || ws_size < 256 * MiB) { fprintf(stderr, "kernel_launch: per_cu %d n_in %d ws %zu: unsupported\n", per_cu, n_in, ws_size); grid = -1; }
    }
    if (grid < 0) return;
    (void)hipMemsetAsync(d_ws, 0, 1u << 20, stream);
    Args a{};
    { const float** f = (const float**)&a; for (int i = 0; i < 20; ++i) f[i] = (const float*)d_in[i]; }
    a.out = (float*)d_out; a.ws = (unsigned char*)d_ws;
    void* kargs[] = {&a};
    hipError_t e = hipLaunchCooperativeKernel((const void*)mk_fwd, dim3(grid), dim3(NTHREADS), kargs, LDS_BYTES, stream);
    if (e != hipSuccess) fprintf(stderr, "cooperative launch failed: %s (grid %d)\n", hipGetErrorString(e), grid);
}
```

```cpp
#include <hip/hip_runtime.h>
#include <hip/hip_cooperative_groups.h>
#include <cstdio>
#include <cstdint>
namespace cg = cooperative_groups;

#define GAS __attribute__((address_space(1)))
#define LAS __attribute__((address_space(3)))
typedef unsigned short bf16;
typedef short bf16x8 __attribute__((ext_vector_type(8)));
typedef short s16x4 __attribute__((ext_vector_type(4)));
typedef float f32x4 __attribute__((ext_vector_type(4)));
typedef _Float16 f16x8 __attribute__((ext_vector_type(8)));
typedef unsigned u32x4 __attribute__((ext_vector_type(4)));
typedef unsigned u32x2 __attribute__((ext_vector_type(2)));

constexpr int NWAVES = 8, NTHREADS = 512;
constexpr int LDS_BYTES = 147456;
constexpr int RING_BYTES = 131072;
constexpr int MISC_OFF = RING_BYTES + 320;
constexpr int HY_W4_OFF = RING_BYTES + 2048;
constexpr int DM = 1024, MTOK = 32768, HTOK = 16384;
constexpr float EPS = 1e-6f;
constexpr size_t MiB = (size_t)1 << 20;
constexpr size_t WS_CTL = 0, WS_WT = 1 * MiB, WS_WBA = 23 * MiB, WS_WBH = 24 * MiB, WS_WO = 26 * MiB, WS_HDN = 28 * MiB, WS_BT = 31 * MiB, WS_XN = 32 * MiB, WS_R = 96 * MiB;
constexpr size_t R_QK = 0, R_VT = 96 * MiB, R_GA = 144 * MiB;
constexpr size_t R_U = 0, R_HS = 96 * MiB, R_XS = 128 * MiB;
constexpr size_t R_MGS = 0, R_MRG = 64 * MiB, R_OUT = 96 * MiB;
constexpr size_t O_AS = 0, O_HST = 16 * MiB, O_ZZ = 48 * MiB;

__device__ __forceinline__ unsigned f2bf(float f) { unsigned u = __builtin_bit_cast(unsigned, f); return (u + 0x7fffu + ((u >> 16) & 1u)) >> 16; }
__device__ __forceinline__ unsigned pk2(float lo, float hi) { return f2bf(lo) | (f2bf(hi) << 16); }
__device__ __forceinline__ float bf2f(unsigned h) { return __builtin_bit_cast(float, h << 16); }
__device__ __forceinline__ float bflo(unsigned w) { return __builtin_bit_cast(float, w << 16); }
__device__ __forceinline__ float bfhi(unsigned w) { return __builtin_bit_cast(float, w & 0xffff0000u); }
__device__ __forceinline__ float sigmoidf_(float x) { return __builtin_amdgcn_rcpf(1.0f + __expf(-x)); }
__device__ __forceinline__ float wave_sum(float v) {
#pragma unroll
    for (int o = 1; o < 64; o <<= 1) v += __shfl_xor(v, o);
    return v;
}
#define LDS_WAIT() asm volatile("s_waitcnt lgkmcnt(0)" ::: "memory")
#ifdef PROBE_SEC
#define SEC_DECL unsigned long long sec_acc = 0ull, sec_t0 = 0ull; (void)sec_t0;
#define SEC_BEGIN(id) do { if ((id) == PROBE_SEC) { __syncthreads(); sec_t0 = __builtin_amdgcn_s_memrealtime(); } } while (0)
#define SEC_END(id) do { if ((id) == PROBE_SEC) { __syncthreads(); sec_acc += __builtin_amdgcn_s_memrealtime() - sec_t0; } } while (0)
#define SEC_SPIN() do { const unsigned long long _s = __builtin_amdgcn_s_memrealtime(); while (__builtin_amdgcn_s_memrealtime() - _s < sec_acc * PROBE_AMP) __builtin_amdgcn_s_sleep(8); sec_acc = 0ull; } while (0)
#define SECW_BEGIN(id) do { if ((id) == PROBE_SEC) { sec_t0 = __builtin_amdgcn_s_memrealtime(); } } while (0)
#define SECW_END(id) do { if ((id) == PROBE_SEC) { asm volatile("s_waitcnt vmcnt(0) lgkmcnt(0)" ::: "memory"); sec_acc += __builtin_amdgcn_s_memrealtime() - sec_t0; } } while (0)
#else
#define SECW_BEGIN(id) do {} while (0)
#define SECW_END(id) do {} while (0)
#define SEC_DECL
#define SEC_BEGIN(id) do {} while (0)
#define SEC_END(id) do {} while (0)
#define SEC_SPIN() do {} while (0)
#endif
#ifndef PROBE_AMP
#define PROBE_AMP 1
#endif

#define XB_TMO      128
#define XB_XCNT(j)  (256  + 64 * (j))
#define XB_XSUB(j)  (1280 + 64 * (j))
#define XB_XGEN(j)  (2304 + 64 * (j))
#define XB_TOP      3328
#define XB_TOPGEN   3392
#define XCD_BAR_WORDS 3456
#define XB_SPIN_CAP (1u << 18)
__device__ __forceinline__ unsigned xb_ld(unsigned* p)              { return __hip_atomic_load(p, __ATOMIC_RELAXED, __HIP_MEMORY_SCOPE_AGENT); }
__device__ __forceinline__ unsigned xb_add(unsigned* p, unsigned v) { return __hip_atomic_fetch_add(p, v, __ATOMIC_RELAXED, __HIP_MEMORY_SCOPE_AGENT); }
__device__ __forceinline__ unsigned xb_xcc_id() { return (unsigned)__builtin_amdgcn_s_getreg((3 << 11) | 20) & 0xFu; }
#define XB_SPIN(cond, bar) do { unsigned _sp = 0; while (cond) { __builtin_amdgcn_s_sleep(1); \
    if ((++_sp & 255u) == 0u) { if (xb_ld(&(bar)[XB_TMO])) break; if (_sp > XB_SPIN_CAP) { atomicAdd(&(bar)[XB_TMO], 1u); break; } } } } while (0)
struct XcdBarrier { unsigned* bar; unsigned x; volatile LAS unsigned* st; };
__device__ __forceinline__ XcdBarrier xcd_barrier_post(unsigned* bar, volatile LAS unsigned* st) {
    XcdBarrier b; b.bar = bar; b.x = xb_xcc_id(); b.st = st;
    if (threadIdx.x == 0) (void)xb_add(&bar[XB_XCNT(b.x)], 1u);
    return b;
}
__device__ __forceinline__ void xcd_barrier_complete(unsigned* bar, unsigned x, unsigned& nloc, unsigned& nx) {
    const unsigned G = gridDim.x * gridDim.y * gridDim.z;
    unsigned sum, cnt, mine, sp = 0u;
    for (;;) {
        sum = 0u; cnt = 0u; mine = 0u;
#pragma unroll
        for (unsigned j = 0; j < 16; ++j) { const unsigned c = xb_ld(&bar[XB_XCNT(j)]); sum += c; cnt += (c > 0u) ? 1u : 0u; mine = (j == x) ? c : mine; }
        if (sum == G) break;
        __builtin_amdgcn_s_sleep(1);
        if ((++sp & 255u) == 0u) { if (xb_ld(&bar[XB_TMO])) break; if (sp > XB_SPIN_CAP) { atomicAdd(&bar[XB_TMO], 1u); break; } }
    }
    nloc = mine > 0u ? mine : 1u; nx = cnt > 0u ? cnt : 1u;
}
__device__ __forceinline__ void xcd_barrier(const XcdBarrier& b) {
    asm volatile("s_waitcnt vmcnt(0)" ::: "memory");
    __syncthreads();
    if (threadIdx.x == 0) {
        unsigned* bar = b.bar;
        __builtin_amdgcn_s_waitcnt(0);
        unsigned nloc = b.st[0], nx = b.st[1];
        if (nloc == 0u) { xcd_barrier_complete(bar, b.x, nloc, nx); b.st[0] = nloc; b.st[1] = nx; }
        const unsigned old = xb_add(&bar[XB_XSUB(b.x)], 1u);
        const unsigned gen = old / nloc;
        if (old + 1u == (gen + 1u) * nloc) {
            __builtin_amdgcn_fence(__ATOMIC_RELEASE, "agent");
            asm volatile("s_waitcnt vmcnt(0)" ::: "memory");
            const unsigned og = xb_add(&bar[XB_TOP], 1u);
            const unsigned tg = og / nx;
            if (og + 1u == (tg + 1u) * nx) xb_add(&bar[XB_TOPGEN], 1u);
            else XB_SPIN(xb_ld(&bar[XB_TOPGEN]) == tg, bar);
            __builtin_amdgcn_fence(__ATOMIC_ACQUIRE, "agent");
            xb_add(&bar[XB_XGEN(b.x)], 1u);
            asm volatile("s_waitcnt vmcnt(0)" ::: "memory");
        } else {
            XB_SPIN(xb_ld(&bar[XB_XGEN(b.x)]) == gen, bar);
            __builtin_amdgcn_fence(__ATOMIC_ACQUIRE, "agent");
            asm volatile("s_waitcnt vmcnt(0)" ::: "memory");
        }
    }
    __syncthreads();
}

struct Args {
    const float *xp, *xs, *rel_bias, *pre_g, *post_g, *w_in, *conv_w, *conv_b, *fw1, *fb1, *fw2, *fb2, *fw3, *fb3, *fw4, *ffreq, *skip, *wba, *wbh, *wout;
    float* out; unsigned char* ws;
};

#define FDEV __device__ __forceinline__
#define FLAS __attribute__((address_space(3)))
#define FFT_OPAQUE(x) asm volatile("" : "+v"(x))
typedef float FC __attribute__((ext_vector_type(2)));
__device__ __forceinline__ float fft_cos_turns(float t) { return __builtin_amdgcn_cosf(t); }
__device__ __forceinline__ float fft_sin_turns(float t) { return __builtin_amdgcn_sinf(t); }

FDEV int fft_swz(int idx) { return idx ^ ((idx >> 4) & 15); }
FDEV FC fft_cmul(FC a, FC b) { FC r; r.x = a.x * b.x - a.y * b.y; r.y = a.x * b.y + a.y * b.x; return r; }

FDEV FC fft_mulw16(FC t, int idx) {
    const float C1 = 0.92387953251128674f, S1 = 0.38268343236508977f, H = 0.70710678118654752f;
    FC r;
    if (idx == 0) { r = t; }
    else if (idx == 4) { r.x = t.y; r.y = -t.x; }
    else if (idx == 2) { r.x = (t.x + t.y) * H; r.y = (t.y - t.x) * H; }
    else if (idx == 6) { r.x = (t.y - t.x) * H; r.y = -(t.x + t.y) * H; }
    else {
        float c, s;
        if (idx == 1) { c = C1; s = S1; } else if (idx == 3) { c = S1; s = C1; } else if (idx == 5) { c = -S1; s = C1; } else { c = -C1; s = S1; }
        r.x = t.x * c + t.y * s; r.y = t.y * c - t.x * s;
    }
    return r;
}
template <int R> FDEV void fft_dft(FC (&a)[R]) {
#pragma unroll
    for (int len = R; len >= 2; len >>= 1) {
        const int half = len >> 1;
#pragma unroll
        for (int g0 = 0; g0 < R; g0 += len) {
#pragma unroll
            for (int k = 0; k < half; ++k) {
                const FC u = a[g0 + k], v = a[g0 + k + half];
                FC su, t; su.x = u.x + v.x; su.y = u.y + v.y; t.x = u.x - v.x; t.y = u.y - v.y;
                a[g0 + k] = su; a[g0 + k + half] = fft_mulw16(t, k * (16 / len));
            }
        }
    }
}
template <int R> FDEV int fft_bitrev(int j) { int r = 0;
#pragma unroll
    for (int b = 1, rb = R >> 1; b < R; b <<= 1, rb >>= 1) if (j & b) r |= rb; return r; }

template <bool PM> FDEV int fft_bi(int tid, int u) { return PM ? (2 * (tid + 512 * (u >> 1)) + (u & 1)) : (tid + 512 * u); }
template <int R, int LOG2N, int LOG2S, bool NOTW, bool PM = false> FDEV void fft_pass_load(const FLAS FC* D, int tid, FC (&v)[32]) {
    FFT_OPAQUE(tid);
    constexpr int LR = (R == 16) ? 4 : (R == 8) ? 3 : (R == 4) ? 2 : 1;
    constexpr int n = 1 << LOG2N, nR = n >> LR;
#pragma unroll
    for (int u = 0; u < 32 / R; ++u) {
        const int bi = fft_bi<PM>(tid, u);
        const int sq = bi >> (LOG2N - LR), i = bi & (nR - 1);
        const int pb = fft_swz(sq * n + i);
        FC a[R];
#pragma unroll
        for (int k = 0; k < R; ++k) a[k] = D[pb + k * nR];
        fft_dft<R>(a);
        if (NOTW) {
#pragma unroll
            for (int j = 0; j < R; ++j) v[u * R + j] = a[fft_bitrev<R>(j)];
        } else {
            const int ps = (i >> LOG2S) << LOG2S;
            const float turns = (float)ps * (1.0f / (float)n);
            FC w[R];
            w[1].x = fft_cos_turns(turns); w[1].y = -fft_sin_turns(turns);
            if (R > 2) { w[2] = fft_cmul(w[1], w[1]); w[3] = fft_cmul(w[2], w[1]); }
            if (R > 4) { w[4] = fft_cmul(w[2], w[2]); w[5] = fft_cmul(w[4], w[1]); w[6] = fft_cmul(w[3], w[3]); w[7] = fft_cmul(w[4], w[3]); }
            if (R > 8) { w[8] = fft_cmul(w[4], w[4]);
#pragma unroll
                for (int j = 9; j < 16; ++j) w[j < R ? j : 0] = fft_cmul(w[8 < R ? 8 : 0], w[(j - 8) < R ? (j - 8) : 0]); }
            v[u * R] = a[0];
#pragma unroll
            for (int j = 1; j < R; ++j) v[u * R + j] = fft_cmul(a[fft_bitrev<R>(j)], w[j]);
        }
    }
}
template <int R, int LOG2N, int LOG2S, bool PM = false> FDEV void fft_pass_store(FLAS FC* D, int tid, const FC (&v)[32]) {
    FFT_OPAQUE(tid);
    constexpr int LR = (R == 16) ? 4 : (R == 8) ? 3 : (R == 4) ? 2 : 1;
    constexpr int n = 1 << LOG2N, nR = n >> LR;
#pragma unroll
    for (int u = 0; u < 32 / R; ++u) {
        const int bi = fft_bi<PM>(tid, u);
        const int sq = bi >> (LOG2N - LR), i = bi & (nR - 1);
        const int q = i & ((1 << LOG2S) - 1), p = i >> LOG2S;
        const int base = sq * n + q + ((R * p) << LOG2S);
        if (LOG2S == 0) {
            const int b2 = base | (p & 15);
#pragma unroll
            for (int j = 0; j < R; ++j) D[b2 ^ j] = v[u * R + j];
        } else if (LOG2S == 4) {
#pragma unroll
            for (int j = 0; j < R; ++j) D[(base ^ j) + 16 * j] = v[u * R + j];
        } else {
            const int b2 = fft_swz(base);
#pragma unroll
            for (int j = 0; j < R; ++j) D[b2 + (j << LOG2S)] = v[u * R + j];
        }
    }
}

template <int LOG2N, bool PM = false> FDEV void fft_first_from_vals(const FC (&in)[2][8], int tid, FC (&v)[32]) {
    constexpr int n = 1 << LOG2N, nR = n >> 4;
#pragma unroll
    for (int u = 0; u < 2; ++u) {
        const int bi = fft_bi<PM>(tid, u), i = bi & (nR - 1);
        FC a[16];
#pragma unroll
        for (int k = 0; k < 8; ++k) { a[k] = in[u][k]; a[k + 8].x = 0.f; a[k + 8].y = 0.f; }
        fft_dft<16>(a);
        const float turns = (float)i * (1.0f / (float)n);
        FC w[16];
        w[1].x = fft_cos_turns(turns); w[1].y = -fft_sin_turns(turns);
        w[2] = fft_cmul(w[1], w[1]); w[3] = fft_cmul(w[2], w[1]);
        w[4] = fft_cmul(w[2], w[2]); w[5] = fft_cmul(w[4], w[1]); w[6] = fft_cmul(w[3], w[3]); w[7] = fft_cmul(w[4], w[3]);
        w[8] = fft_cmul(w[4], w[4]);
#pragma unroll
        for (int j = 9; j < 16; ++j) w[j] = fft_cmul(w[8], w[j - 8]);
        v[u * 16] = a[0];
#pragma unroll
        for (int j = 1; j < 16; ++j) v[u * 16 + j] = fft_cmul(a[fft_bitrev<16>(j)], w[j]);
    }
}
template <int LOG2N, bool PM = false> FDEV void fft_first_from_lds(const FLAS FC* D, int tid, FC (&v)[32]) {
    FFT_OPAQUE(tid);
    constexpr int n = 1 << LOG2N, nR = n >> 4;
    FC in[2][8];
#pragma unroll
    for (int u = 0; u < 2; ++u) {
        const int bi = fft_bi<PM>(tid, u), sq = bi >> (LOG2N - 4), i = bi & (nR - 1);
        const int pb = fft_swz(sq * n + i);
#pragma unroll
        for (int k = 0; k < 8; ++k) in[u][k] = D[pb + k * nR];
    }
    fft_first_from_vals<LOG2N, PM>(in, tid, v);
}

namespace pg8 {
constexpr int BM = 256, BK = 64, HALF = 128, HTB = HALF * BK * 2, STAGE_BYTES = 8 * HTB;
__host__ __device__ __forceinline__ int lds_byte(int r, int c) { const int st = (r >> 4) * 2 + (c >> 5), rr = r & 15, cc = c & 31, ob = rr * 64 + cc * 2; return st * 1024 + (ob ^ (((ob >> 9) & 1) << 5)); }
__host__ __device__ __forceinline__ void stage_rc(int b, int& R, int& C) { const int st = b / 1024, sb = b % 1024, swz = sb ^ (((sb >> 9) & 1) << 5); R = (st >> 1) * 16 + swz / 64; C = (st & 1) * 32 + (swz % 64) / 2; }
__host__ __device__ __forceinline__ int perm32(int rho) { const int n = rho >> 4, i = rho & 15; return 8 * (i >> 2) + 4 * n + (i & 3); }

struct GUnit { const char* A; const char* B; unsigned lda, ldb; int nt, mode; bf16* dst; int ldc; const bf16* aux; int ldaux; float scale; };
__device__ __forceinline__ void unit_order(int l, int nwg, int nM, int nN, int& pm, int& pn) {
    const int q = nwg / 8, xcd = l % 8, off = l / 8; const int wgid = xcd * q + off;
    const int nig = 8 * nN, gid = wgid / nig, fm = gid * 8, gsz = (nM - fm) < 8 ? (nM - fm) : 8;
    pm = fm + ((wgid % nig) % gsz); pn = (wgid % nig) / gsz;
}
__device__ __forceinline__ bool gemm_next(const Args& P, int ph, int hf, int i, int c, int G, GUnit& u) {
    unsigned char* ws = P.ws; const char* WT = (const char*)(ws + WS_WT); const char* XN = (const char*)(ws + WS_XN) + (size_t)hf * HTOK * 2048;
    unsigned char* R = ws + WS_R;
    u.aux = nullptr; u.ldaux = 0; u.scale = 1.f; u.mode = 0; u.lda = 2048; u.ldb = 2048; u.nt = 16;
    const int L = i * G + c;
    if (ph == 1) {
        if (L >= 1280) return false;
        if (L < 896) { int pm, pn; unit_order(L, 896, 64, 14, pm, pn);
            u.A = XN + (size_t)pm * 256 * 2048; u.B = WT + (size_t)pn * 256 * 2048;
            if (pn < 12) { u.dst = (bf16*)(R + R_QK) + (size_t)pm * 256 * 3072 + pn * 256; u.ldc = 3072; u.scale = ((pn & 3) < 2) ? 0.125f : 1.f; }
            else { u.dst = (bf16*)(R + R_GA) + (size_t)pm * 256 * 512 + (pn - 12) * 256; u.ldc = 512; u.mode = 1; }
        } else { int l = L - 896; const int g = l / 128; l -= g * 128; int pm, pn; unit_order(l, 128, 2, 64, pm, pn);
            const int r = (g == 0) ? 1 : (g == 1 ? 4 : 16), S = hf ? 4096 : 8192, tps = S / 256, seq = pn / tps, tq = (pn % tps) * 256, lr = S / r, cc = tq / lr, i0 = tq % lr;
            u.A = WT + (size_t)(3584 + g * 512 + pm * 256) * 2048;
            u.B = XN + (size_t)(seq * S + i0 * r + cc) * 2048; u.ldb = 2048u * r;
            u.dst = (bf16*)(R + R_VT) + (size_t)(g * 512 + pm * 256) * HTOK + pn * 256; u.ldc = HTOK; }
        return true;
    }
    if (ph == 3) {
        if (L >= 1024) return false; int pm, pn; unit_order(L, 1024, 16, 64, pm, pn);
        u.A = WT + (size_t)(5120 + pm * 256) * 2048; u.B = XN + (size_t)pn * 256 * 2048; u.ldc = HTOK;
        if (pm < 12) u.dst = (bf16*)(R + R_U) + (size_t)pm * 256 * HTOK + pn * 256;
        else { u.dst = (bf16*)(R + R_HS) + (size_t)(pm - 12) * 256 * HTOK + pn * 256; u.mode = 1; }
        return true;
    }
    if (ph == 6) {
        const int tile = c + (i >> 2) * G, sub = i & 3; if (tile >= 256) return false;
        const int pm = tile >> 2, pn = tile & 3;
        bf16* MGS = (bf16*)(R + R_MGS) + (size_t)pm * 256 * 2048 + pn * 256; bf16* MRG = (bf16*)(R + R_MRG) + (size_t)pm * 256 * 1024 + pn * 256;
        const char* OS = (const char*)P.out + (size_t)hf * 64 * MiB;
        if (sub < 2) { u.A = XN + (size_t)pm * 256 * 2048; u.B = WT + (size_t)(9216 + sub * 1024 + pn * 256) * 2048; u.dst = MGS + sub * 1024; u.ldc = 2048; u.mode = 2; }
        else if (sub == 2) { u.A = OS + O_AS + (size_t)pm * 256 * 1024; u.lda = 1024; u.B = (const char*)(ws + WS_WBA) + (size_t)pn * 256 * 1024; u.ldb = 1024; u.nt = 8;
            u.dst = MRG; u.ldc = 1024; u.aux = MGS; u.ldaux = 2048; u.mode = 3; }
        else { u.A = (const char*)(R + R_HS) + (size_t)pm * 256 * 2048; u.B = (const char*)(ws + WS_WBH) + (size_t)pn * 256 * 2048; u.dst = MRG; u.ldc = 1024; u.aux = MGS + 1024; u.ldaux = 2048; u.mode = 4; }
        return true;
    }
    if (L >= 256) return false;
    { int pm, pn; unit_order(L, 256, 64, 4, pm, pn);
      u.A = (const char*)(R + R_MRG) + (size_t)pm * 256 * 2048; u.B = (const char*)(ws + WS_WO) + (size_t)pn * 256 * 2048;
      u.dst = (bf16*)(R + R_OUT) + (size_t)pm * 256 * 1024 + pn * 256; u.ldc = 1024; }
    return true;
}

__device__ __forceinline__ void gemm_epi(const f32x4 (&acc)[2][2][4][2], const GUnit& u, int wr, int wc, int fr, int fq) {
    const int row0 = wr * 64 + fr, col0 = wc * 32 + 8 * fq;
#pragma unroll
    for (int ai = 0; ai < 2; ++ai)
#pragma unroll
        for (int m = 0; m < 4; ++m) {
            const int row = row0 + ai * HALF + m * 16;
            bf16* rowp = u.dst + (size_t)row * u.ldc + col0;
#pragma unroll
            for (int bj = 0; bj < 2; ++bj) {
                f32x4 v0 = acc[ai][bj][m][0], v1 = acc[ai][bj][m][1];
                float v[8] = {v0[0], v0[1], v0[2], v0[3], v1[0], v1[1], v1[2], v1[3]};
                if (u.mode == 0) {
#pragma unroll
                    for (int e = 0; e < 8; ++e) v[e] *= u.scale;
                } else if (u.mode == 1) {
#pragma unroll
                    for (int e = 0; e < 8; ++e) v[e] = v[e] * sigmoidf_(v[e]);
                } else if (u.mode == 2) {
#pragma unroll
                    for (int e = 0; e < 8; ++e) v[e] = sigmoidf_(v[e]);
                } else {
                    const u32x4 gw = *(const u32x4*)(u.aux + (size_t)row * u.ldaux + col0 + bj * HALF);
                    float g[8] = {bflo(gw.x), bfhi(gw.x), bflo(gw.y), bfhi(gw.y), bflo(gw.z), bfhi(gw.z), bflo(gw.w), bfhi(gw.w)};
                    if (u.mode == 3) {
#pragma unroll
                        for (int e = 0; e < 8; ++e) v[e] = g[e] * v[e];
                    } else {
                        const u32x4 pw = *(const u32x4*)(rowp + bj * HALF);
                        float p[8] = {bflo(pw.x), bfhi(pw.x), bflo(pw.y), bfhi(pw.y), bflo(pw.z), bfhi(pw.z), bflo(pw.w), bfhi(pw.w)};
#pragma unroll
                        for (int e = 0; e < 8; ++e) v[e] = p[e] + g[e] * v[e];
                    }
                }
                u32x4 w; w.x = pk2(v[0], v[1]); w.y = pk2(v[2], v[3]); w.z = pk2(v[4], v[5]); w.w = pk2(v[6], v[7]);
                *(u32x4*)(rowp + bj * HALF) = w;
            }
        }
}

__device__ __forceinline__ void gemm_phase(LAS unsigned char* lds, const Args& P, int ph, int hf, int c, int G) {
    int tid = threadIdx.x; asm volatile("" : "+v"(tid));
    const int wid = __builtin_amdgcn_readfirstlane(tid >> 6), lane = tid & 63, wr = wid >> 2, wc = wid & 3, fr = lane & 15, fq = lane >> 4;
    unsigned RAv, RBv, C2v; { int R_, C_; stage_rc(tid * 16, R_, C_); RAv = (unsigned)R_; RBv = (unsigned)((R_ & ~31) + perm32(R_ & 31)); C2v = (unsigned)(C_ * 2); }
    const unsigned ldsw = (unsigned)wid * 1024u;
    const int aoff = lds_byte(wr * 64 + fr, fq * 8), boff = lds_byte(wc * 32 + fr, fq * 8);
#define PG8_SA(b, h) (((b) * 2 + (h)) * HTB)
#define PG8_SB(b, h) ((4 + (b) * 2 + (h)) * HTB)
#define PG8_STAGE(bufoff, gbase, ld, ISB) do { const unsigned _o = ((ISB) ? RBv : RAv) * (unsigned)(ld) + C2v; const char* _g = (const char*)(gbase); \
        __builtin_amdgcn_global_load_lds((const unsigned*)(_g + (size_t)_o), (LAS unsigned*)(lds + (bufoff) + ldsw), 16, 0, 0); \
        __builtin_amdgcn_global_load_lds((const unsigned*)(_g + (size_t)(64u * (unsigned)(ld)) + (size_t)_o), (LAS unsigned*)(lds + (bufoff) + ldsw + 8192), 16, 0, 0); } while (0)
#define RA 0
#define RB 1
#define PG8_LDA(dst, b, h) do { _Pragma("unroll") for (int m = 0; m < 4; ++m) _Pragma("unroll") for (int k = 0; k < 2; ++k) dst[m][k] = *(const LAS bf16x8*)(lds + PG8_SA(b, h) + aoff + m * 2048 + k * 1024); } while (0)
#define PG8_LDB(dst, b, h) do { _Pragma("unroll") for (int n = 0; n < 2; ++n) _Pragma("unroll") for (int k = 0; k < 2; ++k) dst[n][k] = *(const LAS bf16x8*)(lds + PG8_SB(b, h) + boff + n * 2048 + k * 1024); } while (0)
#define PG8_MMA(ai, bj, At, Bt) do { __builtin_amdgcn_s_setprio(1); _Pragma("unroll") for (int m = 0; m < 4; ++m) _Pragma("unroll") for (int n = 0; n < 2; ++n) _Pragma("unroll") for (int k = 0; k < 2; ++k) \
        acc[ai][bj][m][n] = __builtin_amdgcn_mfma_f32_16x16x32_bf16(Bt[n][k], At[m][k], acc[ai][bj][m][n], 0, 0, 0); __builtin_amdgcn_s_setprio(0); } while (0)
#define PG8_WAIT_V(n) asm volatile("s_waitcnt vmcnt(" #n ")" ::: "memory")
#define PG8_WAIT_L(n) asm volatile("s_waitcnt lgkmcnt(" #n ")" ::: "memory")
#define PG8_BAR __builtin_amdgcn_s_barrier()
#define PG8_SCHED __builtin_amdgcn_sched_barrier(0)
    int ui = 0;
    const char* cA; const char* cB; unsigned clda, cldb; int nt;
    { GUnit u0; if (!gemm_next(P, ph, hf, 0, c, G, u0)) return; cA = u0.A; cB = u0.B; clda = u0.lda; cldb = u0.ldb; nt = u0.nt; }
    f32x4 acc[2][2][4][2];
#pragma unroll
    for (int a = 0; a < 2; ++a)
#pragma unroll
        for (int b = 0; b < 2; ++b)
#pragma unroll
            for (int m = 0; m < 4; ++m)
#pragma unroll
                for (int n = 0; n < 2; ++n) acc[a][b][m][n] = (f32x4){0.f, 0.f, 0.f, 0.f};
    bf16x8 At[4][2], B0[2][2], B1[2][2];
    const size_t kstep = 128;
    {
        const size_t hA = (size_t)HALF * clda, hB = (size_t)HALF * cldb;
        PG8_STAGE(PG8_SB(0, 0), cB, cldb, RB); PG8_STAGE(PG8_SB(0, 1), cB + hB, cldb, RB); PG8_STAGE(PG8_SA(0, 0), cA, clda, RA); PG8_STAGE(PG8_SA(0, 1), cA + hA, clda, RA);
        if (wr == 1) PG8_BAR;
        PG8_WAIT_V(2); PG8_BAR;
        PG8_STAGE(PG8_SB(1, 0), cB + kstep, cldb, RB); PG8_STAGE(PG8_SA(1, 0), cA + kstep, clda, RA); PG8_STAGE(PG8_SB(1, 1), cB + hB + kstep, cldb, RB);
        PG8_WAIT_V(6); PG8_BAR;
    }
    for (;;) {
        bool has_next = false; const char* nA = cA; const char* nB = cB; unsigned nlda = clda, nldb = cldb; int nnt = nt;
        const size_t hA = (size_t)HALF * clda;
        for (int t = 0; t < nt; t += 2) {
            const bool last = (t == nt - 2);
            if (last) { GUnit un; has_next = gemm_next(P, ph, hf, ui + 1, c, G, un); if (has_next) { nA = un.A; nB = un.B; nlda = un.lda; nldb = un.ldb; nnt = un.nt; } }
            const char* a1 = cA + (size_t)(t + 1) * kstep;
            const char* a2 = last ? nA : cA + (size_t)(t + 2) * kstep; const char* b2 = last ? nB : cB + (size_t)(t + 2) * kstep;
            const unsigned lda2 = last ? nlda : clda, ldb2 = last ? nldb : cldb; const size_t hA2 = (size_t)HALF * lda2, hB2 = (size_t)HALF * ldb2;
            const char* a3 = a2 + kstep; const char* b3 = b2 + kstep;
            PG8_LDB(B0, 0, 0); PG8_LDB(B1, 0, 1); PG8_SCHED; PG8_LDA(At, 0, 0); PG8_STAGE(PG8_SA(1, 1), a1 + hA, clda, RA);
            PG8_WAIT_V(8); PG8_WAIT_L(0); PG8_BAR; PG8_MMA(0, 0, At, B0); PG8_MMA(0, 1, At, B1); PG8_BAR; PG8_SCHED;
            PG8_LDA(At, 0, 1); PG8_STAGE(PG8_SB(0, 0), b2, ldb2, RB); PG8_STAGE(PG8_SB(0, 1), b2 + hB2, ldb2, RB); PG8_STAGE(PG8_SA(0, 0), a2, lda2, RA);
            PG8_WAIT_V(8); PG8_WAIT_L(0); PG8_BAR; PG8_MMA(1, 0, At, B0); PG8_MMA(1, 1, At, B1); PG8_BAR; PG8_SCHED;
            PG8_LDB(B0, 1, 0); PG8_LDB(B1, 1, 1); PG8_SCHED; PG8_LDA(At, 1, 0); PG8_STAGE(PG8_SA(0, 1), a2 + hA2, lda2, RA);
            PG8_WAIT_V(8); PG8_WAIT_L(0); PG8_BAR; PG8_MMA(0, 0, At, B0); PG8_MMA(0, 1, At, B1); PG8_BAR; PG8_SCHED;
            PG8_LDA(At, 1, 1); PG8_STAGE(PG8_SB(1, 0), b3, ldb2, RB); PG8_STAGE(PG8_SB(1, 1), b3 + hB2, ldb2, RB); PG8_STAGE(PG8_SA(1, 0), a3, lda2, RA);
            PG8_WAIT_V(8); PG8_WAIT_L(0); PG8_BAR; PG8_MMA(1, 0, At, B0); PG8_MMA(1, 1, At, B1); PG8_BAR; PG8_SCHED;
        }
        if (wr == 0) PG8_BAR;
        { GUnit ue; (void)gemm_next(P, ph, hf, ui, c, G, ue); gemm_epi(acc, ue, wr, wc, fr, fq); }
        if (!has_next) break;
#pragma unroll
        for (int a = 0; a < 2; ++a)
#pragma unroll
            for (int b = 0; b < 2; ++b)
#pragma unroll
                for (int m = 0; m < 4; ++m)
#pragma unroll
                    for (int n = 0; n < 2; ++n) acc[a][b][m][n] = (f32x4){0.f, 0.f, 0.f, 0.f};
        cA = nA; cB = nB; clda = nlda; cldb = nldb; nt = nnt; ++ui;
        if (wr == 1) PG8_BAR;
    }
    PG8_WAIT_V(0);
    PG8_BAR;
#undef PG8_SA
#undef PG8_SB
#undef PG8_STAGE
#undef RA
#undef RB
#undef PG8_LDA
#undef PG8_LDB
#undef PG8_MMA
#undef PG8_WAIT_V
#undef PG8_WAIT_L
#undef PG8_BAR
#undef PG8_SCHED
}
}

__device__ __forceinline__ void p0_transpose_item(const float* W, int ldw, int c0, int ncols, int K, bf16* WT, int row_off, LAS float* scr, int item, int lane) {
    const int nblk = ncols / 32, kb = item / nblk, nb = item % nblk, k0 = 64 * kb, n0 = 32 * nb;
#pragma unroll 8
    for (int i = 0; i < 32; ++i) { const int kk = 2 * i + (lane >> 5); scr[kk * 33 + (lane & 31)] = W[(size_t)(k0 + kk) * ldw + c0 + n0 + (lane & 31)]; }
    LDS_WAIT(); asm volatile("" ::: "memory");
    const int c = lane & 7;
#pragma unroll
    for (int j = 0; j < 4; ++j) { const int n = (lane >> 3) + 8 * j; const LAS float* s = scr + (8 * c) * 33 + n;
        u32x4 o; o.x = pk2(s[0 * 33], s[1 * 33]); o.y = pk2(s[2 * 33], s[3 * 33]); o.z = pk2(s[4 * 33], s[5 * 33]); o.w = pk2(s[6 * 33], s[7 * 33]);
        *(u32x4*)(WT + (size_t)(row_off + n0 + n) * K + k0 + 8 * c) = o; }
    LDS_WAIT(); asm volatile("" ::: "memory");
}
__device__ __forceinline__ float rdlane(float v, int l) { return __builtin_bit_cast(float, __builtin_amdgcn_readlane(__builtin_bit_cast(int, v), l)); }

__device__ __forceinline__ void p0_prologue(const Args& P, LAS unsigned char* lds, int vcu, int G, int wave, int lane) {
    LAS float* scr = (LAS float*)(lds + wave * 16384);
    const int gw = vcu * NWAVES + wave, NGW = G * NWAVES;
    unsigned char* ws = P.ws;
    constexpr int IT_BLK = 16 * 16;
    constexpr int NIT = 22 * IT_BLK + (512 / 64) * (1024 / 32) + 2 * (1024 / 64) * (1024 / 32);
    for (int it = gw; it < NIT; it += NGW) {
        int r = it;
        if (r < 22 * IT_BLK) { const int b = r / IT_BLK; r -= b * IT_BLK;
            const int src = (b == 0) ? 0 : (b == 1) ? 3 : (b == 2) ? 1 : (b == 3) ? 4 : (b == 4) ? 2 : (b == 5) ? 5 : (b == 6) ? 9 : (b == 7) ? 6 : (b == 8) ? 7 : (b == 9) ? 8 : b;
            p0_transpose_item(P.w_in, 11264, src * 512, 512, 1024, (bf16*)(ws + WS_WT), b * 512, scr, r, lane); continue; }
        r -= 22 * IT_BLK;
        if (r < 256) { p0_transpose_item(P.wba, 1024, 0, 1024, 512, (bf16*)(ws + WS_WBA), 0, scr, r, lane); continue; }
        r -= 256;
        if (r < 512) { p0_transpose_item(P.wbh, 1024, 0, 1024, 1024, (bf16*)(ws + WS_WBH), 0, scr, r, lane); continue; }
        r -= 512;
        p0_transpose_item(P.wout, 1024, 0, 1024, 1024, (bf16*)(ws + WS_WO), 0, scr, r, lane);
    }
    {
        f32x4 g4[4];
#pragma unroll
        for (int j = 0; j < 4; ++j) g4[j] = ((const f32x4*)P.pre_g)[lane + 64 * j];
        for (int m = gw; m < MTOK; m += NGW) {
            const float* xrow = (m < HTOK) ? P.xp + (size_t)m * DM : P.xs + (size_t)(m - HTOK) * DM;
            const f32x4* xr = (const f32x4*)xrow + lane;
            f32x4 v[4]; float s = 0.f;
#pragma unroll
            for (int j = 0; j < 4; ++j) { v[j] = xr[64 * j]; s += (v[j].x * v[j].x + v[j].y * v[j].y) + (v[j].z * v[j].z + v[j].w * v[j].w); }
            const float rstd = 1.0f / sqrtf(wave_sum(s) * (1.f / DM) + EPS);
            unsigned long long* o8 = (unsigned long long*)((bf16*)(ws + WS_XN) + (size_t)m * DM) + lane;
#pragma unroll
            for (int j = 0; j < 4; ++j) o8[64 * j] = (unsigned long long)pk2(v[j].x * rstd * g4[j].x, v[j].y * rstd * g4[j].y) | ((unsigned long long)pk2(v[j].z * rstd * g4[j].z, v[j].w * rstd * g4[j].w) << 32);
        }
    }
    {
        const float fr = P.ffreq[lane], b1 = P.fb1[lane], b2 = P.fb2[lane], b3 = P.fb3[lane];
        for (int row = gw; row < 12288; row += NGW) {
            const int Lf = (row < 8192) ? 8192 : 4096, t = (row < 8192) ? row : row - 8192;
            const float tt = (float)t * (1.0f / (float)(Lf - 1));
            const float ang = (6.283185307179586f / (float)Lf) * (float)t;
            const int k = (lane >= 17) ? lane - 17 : lane - 1;
            const float band = 1e-4f + (float)(k & 15) * ((15.0f - 1e-4f) / 15.0f);
            const float a = ang * band;
            float z = (lane == 0) ? tt : ((lane <= 16) ? cosf(a) : -sinf(a));
            float acc = b1;
#pragma unroll
            for (int i = 0; i < 33; ++i) acc += rdlane(z, i) * P.fw1[i * 64 + lane];
            float h = sinf(fr * acc);
            acc = b2;
#pragma unroll 16
            for (int i = 0; i < 64; ++i) acc += rdlane(h, i) * P.fw2[i * 64 + lane];
            h = sinf(fr * acc);
            acc = b3;
#pragma unroll 16
            for (int i = 0; i < 64; ++i) acc += rdlane(h, i) * P.fw3[i * 64 + lane];
            h = sinf(fr * acc);
            ((_Float16*)(ws + WS_HDN))[(size_t)row * 64 + lane] = (_Float16)h;
        }
    }
    {
        float* BT = (float*)(ws + WS_BT);
        for (int e = gw * 64 + lane; e < 3 * 8 * 129; e += NGW * 64) {
            const int g = e / (8 * 129), h = (e / 129) % 8, dd = e % 129;
            const int r = (g == 0) ? 1 : (g == 1 ? 4 : 16);
            const int rel = (dd - 64) * r; const int n = rel < 0 ? -rel : rel;
            const float nf = (float)(n > 1 ? n : 1);
            int large = 8 + (int)(logf(nf / 8.0f) / 4.852030263919617f * 8.0f);
            large = large < 15 ? large : 15;
            const int bucket = (rel > 0 ? 16 : 0) + (n < 8 ? n : large);
            BT[e] = P.rel_bias[bucket * 24 + g * 8 + h];
        }
    }
}

constexpr int AT_KS = 0, AT_VS = 49152, AT_VROW = 776, AT_BT = AT_VS + 64 * AT_VROW;
constexpr size_t WS_LSE = WS_HDN + 2 * MiB - 512 * 1024;
#ifdef PROBE_SEC
#define SEC_PARM3 , unsigned long long& sec_acc
#define SEC_ARG3 , sec_acc
#else
#define SEC_PARM3
#define SEC_ARG3
#endif
__device__ __forceinline__ void attn_unit(const Args& P, LAS unsigned char* lds, int hf, int g, int u, int tid, int wave, int lane SEC_PARM3) {
#ifdef PROBE_SEC
    unsigned long long sec_t0 = 0ull; (void)sec_t0;
#endif
    const int S = hf ? 4096 : 8192, r = (g == 0) ? 1 : (g == 1 ? 4 : 16), lr = S / r, nchunk = lr / 256;
    const int h = u & 7; int rest = u >> 3; const int chunk = rest % nchunk; rest /= nchunk; const int c = rest % r, seq = rest / r;
    const int hs = seq * S, i0 = chunk * 256, kbase = i0 - 64;
    unsigned char* R = P.ws + WS_R;
    const bf16* QK = (const bf16*)(R + R_QK); const bf16* VT = (const bf16*)(R + R_VT); const bf16* GA = (const bf16*)(R + R_GA);
    bf16* OS = (bf16*)((unsigned char*)P.out + (size_t)hf * 64 * MiB + O_AS);
    float* LS = (float*)(P.ws + WS_LSE);
    LAS float* BTL = (LAS float*)(lds + AT_BT);
    SECW_BEGIN(11);
    {
        const bf16* kg = QK + g * 1024 + 512 + h * 64; const bf16* vg = VT + (size_t)(g * 512 + h * 64) * HTOK + hs + c * lr;
        u32x4 kv[6], vv[6];
#pragma unroll
        for (int it = 0; it < 6; ++it) { const int idx = tid + 512 * it;
            { const int kk = idx >> 3, ch = idx & 7, ki = kbase + kk; kv[it] = (u32x4){0u, 0u, 0u, 0u};
              if (ki >= 0 && ki < lr) kv[it] = *(const u32x4*)(kg + (size_t)(hs + ki * r + c) * 3072 + ch * 8); }
            { const int d = idx / 48, kc = idx - d * 48, ki = kbase + 8 * kc; vv[it] = (u32x4){0u, 0u, 0u, 0u};
              if (ki >= 0 && ki < lr) vv[it] = *(const u32x4*)(vg + (size_t)d * HTOK + ki); } }
        if (tid < 129) BTL[tid] = ((const float*)(P.ws + WS_BT))[(g * 8 + h) * 129 + tid];
#pragma unroll
        for (int it = 0; it < 6; ++it) { const int idx = tid + 512 * it;
            { const int kk = idx >> 3, ch = idx & 7; *(LAS u32x4*)(lds + AT_KS + kk * 128 + ((ch ^ (kk & 7)) << 4)) = kv[it]; }
            { const int d = idx / 48, kc = idx - d * 48; const u32x2 lo = {vv[it].x, vv[it].y}, hi = {vv[it].z, vv[it].w};
              *(LAS u32x2*)(lds + AT_VS + d * AT_VROW + kc * 16) = lo; *(LAS u32x2*)(lds + AT_VS + d * AT_VROW + kc * 16 + 8) = hi; } }
    }
    __syncthreads();
    SECW_END(11);
    const int a = lane & 15, gq = lane >> 4;
#pragma unroll 1
    for (int j = wave; j < 16; j += 8) {
        SECW_BEGIN(12);
        const int it0 = i0 + 16 * j;
        const size_t row = (size_t)(hs + (it0 + a) * r + c);
        const bf16* qp = QK + row * 3072 + g * 1024 + h * 64 + 8 * gq;
        const bf16x8 q0 = *(const bf16x8*)qp, q1 = *(const bf16x8*)(qp + 32);
        u32x2 orun[4]; float lrun = 0.f; u32x2 gate[4];
        if (g > 0) { lrun = LS[row * 8 + h];
#pragma unroll
            for (int dt = 0; dt < 4; ++dt) orun[dt] = *(const u32x2*)(OS + row * 512 + h * 64 + 16 * dt + 4 * gq); }
        if (g == 2) {
#pragma unroll
            for (int dt = 0; dt < 4; ++dt) gate[dt] = *(const u32x2*)(GA + row * 512 + h * 64 + 16 * dt + 4 * gq); }
        f32x4 s[9];
#pragma unroll
        for (int kt = 0; kt < 9; ++kt) {
            const int kk = 16 * j + 16 * kt + a;
            const bf16x8 k0 = *(const LAS bf16x8*)(lds + AT_KS + kk * 128 + ((gq ^ (kk & 7)) << 4));
            const bf16x8 k1 = *(const LAS bf16x8*)(lds + AT_KS + kk * 128 + (((gq + 4) ^ (kk & 7)) << 4));
            f32x4 z = {0.f, 0.f, 0.f, 0.f};
            z = __builtin_amdgcn_mfma_f32_16x16x32_bf16(k0, q0, z, 0, 0, 0);
            s[kt] = __builtin_amdgcn_mfma_f32_16x16x32_bf16(k1, q1, z, 0, 0, 0);
        }
        float mx = -1e30f;
        const int db = 4 * gq - a;
#pragma unroll
        for (int kt = 0; kt < 9; ++kt) {
            const int ki0 = it0 - 64 + 16 * kt; const bool tv = (ki0 >= 0) && (ki0 < lr);
#pragma unroll
            for (int rg = 0; rg < 4; ++rg) {
                const int dd = db + 16 * kt + rg;
                bool ok = tv; if (kt == 0) ok = ok && (dd >= 0); if (kt == 8) ok = ok && (dd <= 128);
                const int di = (kt == 0) ? (dd < 0 ? 0 : dd) : ((kt == 8) ? (dd > 128 ? 128 : dd) : dd);
                const float v = ok ? s[kt][rg] + BTL[di] : -1e30f;
                s[kt][rg] = v; mx = fmaxf(mx, v);
            }
        }
        mx = fmaxf(mx, __shfl_xor(mx, 16)); mx = fmaxf(mx, __shfl_xor(mx, 32));
        float ls = 0.f;
#pragma unroll
        for (int kt = 0; kt < 9; ++kt)
#pragma unroll
            for (int rg = 0; rg < 4; ++rg) { const float p = __expf(s[kt][rg] - mx); s[kt][rg] = p; ls += p; }
        ls += __shfl_xor(ls, 16); ls += __shfl_xor(ls, 32);
        SECW_END(12);
        SECW_BEGIN(13);
        f32x4 o[4];
#pragma unroll
        for (int dt = 0; dt < 4; ++dt) o[dt] = (f32x4){0.f, 0.f, 0.f, 0.f};
#pragma unroll
        for (int pp = 0; pp < 5; ++pp) {
            const int kt0 = 2 * pp, kt1 = 2 * pp + 1;
            bf16x8 pf;
            { const unsigned w0 = pk2(s[kt0][0], s[kt0][1]), w1 = pk2(s[kt0][2], s[kt0][3]);
              unsigned w2 = 0u, w3 = 0u; if (kt1 < 9) { w2 = pk2(s[kt1 < 9 ? kt1 : 8][0], s[kt1 < 9 ? kt1 : 8][1]); w3 = pk2(s[kt1 < 9 ? kt1 : 8][2], s[kt1 < 9 ? kt1 : 8][3]); }
              const u32x4 pw = {w0, w1, w2, w3}; pf = __builtin_bit_cast(bf16x8, pw); }
#pragma unroll
            for (int dt = 0; dt < 4; ++dt) {
                const LAS unsigned char* vp = lds + AT_VS + (16 * dt + a) * AT_VROW + (16 * j + 4 * gq) * 2;
                const u32x2 va = *(const LAS u32x2*)(vp + kt0 * 32);
                u32x2 vb = {0u, 0u}; if (kt1 < 9) vb = *(const LAS u32x2*)(vp + (kt1 < 9 ? kt1 : 8) * 32);
                const u32x4 vw = {va.x, va.y, vb.x, vb.y};
                o[dt] = __builtin_amdgcn_mfma_f32_16x16x32_bf16(__builtin_bit_cast(bf16x8, vw), pf, o[dt], 0, 0, 0);
            }
        }
        float inv = 1.0f / ls, lse = mx + __logf(ls), wr_ = 0.f;
        if (g > 0) { const float m = fmaxf(lrun, lse); const float e0 = __expf(lrun - m), e1 = __expf(lse - m); const float it_ = 1.0f / (e0 + e1);
            wr_ = e0 * it_; inv *= e1 * it_; lse = m + __logf(e0 + e1); }
#pragma unroll
        for (int dt = 0; dt < 4; ++dt) {
            float v0 = o[dt][0] * inv, v1 = o[dt][1] * inv, v2 = o[dt][2] * inv, v3 = o[dt][3] * inv;
            if (g > 0) { v0 += wr_ * bflo(orun[dt].x); v1 += wr_ * bfhi(orun[dt].x); v2 += wr_ * bflo(orun[dt].y); v3 += wr_ * bfhi(orun[dt].y); }
            if (g == 2) { v0 *= bflo(gate[dt].x); v1 *= bfhi(gate[dt].x); v2 *= bflo(gate[dt].y); v3 *= bfhi(gate[dt].y); }
            const u32x2 w = {pk2(v0, v1), pk2(v2, v3)};
            *(u32x2*)(OS + row * 512 + h * 64 + 16 * dt + 4 * gq) = w;
        }
        if (g < 2 && gq == 0) LS[row * 8 + h] = lse;
        SECW_END(13);
    }
    __syncthreads();
}

template <int LOG2N> __device__ __forceinline__ void fft16k_t(LAS FC* Dd, int tid) {
    FC v[32];
    fft_pass_load<16, LOG2N, 0, false>(Dd, tid, v); __syncthreads(); fft_pass_store<16, LOG2N, 0>(Dd, tid, v); __syncthreads();
    fft_pass_load<16, LOG2N, 4, false>(Dd, tid, v); __syncthreads(); fft_pass_store<16, LOG2N, 4>(Dd, tid, v); __syncthreads();
    fft_pass_load<16, LOG2N, 8, false>(Dd, tid, v); __syncthreads(); fft_pass_store<16, LOG2N, 8>(Dd, tid, v); __syncthreads();
    constexpr int RL = (LOG2N == 14) ? 4 : 2;
    fft_pass_load<RL, LOG2N, 12, true>(Dd, tid, v); __syncthreads(); fft_pass_store<RL, LOG2N, 12>(Dd, tid, v); __syncthreads();
}
__device__ __forceinline__ void fft16k(LAS FC* Dd, int log2n, int tid) {
    if (log2n == 14) fft16k_t<14>(Dd, tid); else fft16k_t<13>(Dd, tid);
}
__device__ __forceinline__ float sconv(const bf16* row, int t, int Ls, float w0, float w1, float w2, float b) {
    const float um = (t > 0) ? bf2f(row[t - 1]) : 0.f, u0 = bf2f(row[t]), up = (t < Ls - 1) ? bf2f(row[t + 1]) : 0.f;
    return um * w0 + u0 * w1 + up * w2 + b;
}
struct SC2 { unsigned wp, wc, wn; };
__device__ __forceinline__ SC2 sc_load(const bf16* row, int t, int Ls) {
    SC2 s; const unsigned* p = (const unsigned*)(row + t);
    s.wc = p[0]; s.wp = (t >= 2) ? p[-1] : 0u; s.wn = (t + 2 < Ls) ? p[1] : 0u; return s;
}
__device__ __forceinline__ FC sc_eval(const SC2& s, float w0, float w1, float w2, float b) {
    const float um = bfhi(s.wp), u0 = bflo(s.wc), u1 = bfhi(s.wc), u2 = bflo(s.wn);
    FC r; r.x = um * w0 + u0 * w1 + u1 * w2 + b; r.y = u0 * w0 + u1 * w1 + u2 * w2 + b; return r;
}
#ifdef PROBE_SEC
#define SEC_PARM , unsigned long long& sec_acc
#define SEC_ARG , sec_acc
#else
#define SEC_PARM
#define SEC_ARG
#endif
#define FFT_MID(L2N, LS) do { fft_pass_load<16, L2N, LS, false>(Dd, tid, v); __syncthreads(); fft_pass_store<16, L2N, LS>(Dd, tid, v); __syncthreads(); } while (0)
template <int LOG2N> __device__ __forceinline__ void hyena_unit_t(const Args& P, LAS unsigned char* lds, int c, int tid SEC_PARM) {
#ifdef PROBE_SEC
    unsigned long long sec_t0 = 0ull; (void)sec_t0;
#endif
    constexpr int hf = (LOG2N == 13) ? 1 : 0, Ls = 1 << (LOG2N - 1), N = 1 << LOG2N, nR = N >> 4, RL = (LOG2N == 14) ? 4 : 2, NBF = 32 / RL, NV = RL / 2, LRL = (RL == 4) ? 2 : 1;
    LAS FC* Dd = (LAS FC*)lds;
    LAS float* Df = (LAS float*)lds;
    unsigned char* R = P.ws + WS_R;
    const bf16* U = (const bf16*)(R + R_U); const bf16* GH = (const bf16*)(R + R_HS); bf16* HS2 = (bf16*)((unsigned char*)P.out + (size_t)hf * 64 * MiB + O_HST);
    FC* Xs = (FC*)(R + R_XS) + (size_t)blockIdx.x * 16384;
    FC v[32];
    SEC_BEGIN(1);
    asm volatile("" : "+v"(tid));
    {
        const int lane = tid & 63, wave = __builtin_amdgcn_readfirstlane(tid >> 6), col = lane & 15, kq = lane >> 4;
        if (tid == 0) { FC z = {0.f, 0.f}; Dd[fft_swz(Ls)] = z; }
        if (hf) for (int e = tid; e < 8192; e += NTHREADS) { FC z = {0.f, 0.f}; Dd[fft_swz(8192 + e)] = z; }
        f16x8 Bh[2], Bl[2];
#pragma unroll
        for (int s = 0; s < 2; ++s) {
#pragma unroll
            for (int i8 = 0; i8 < 8; ++i8) { const int j = 32 * s + 8 * kq + i8; const float w = (col < 4) ? 256.0f * P.fw4[(size_t)j * 4096 + col * 1024 + c] : 0.f;
                const _Float16 h = (_Float16)w; Bh[s][i8] = h; Bl[s][i8] = (_Float16)(w - (float)h); } }
        const float delta = fabsf(-3.0701134573253945f + (float)c * ((-15.350567286626973f + 3.0701134573253945f) / 1023.0f));
        const float tsc = -delta * (1.0f / (float)(Ls - 1));
        const float skp = (col < 4) ? P.skip[(col >> 1) * 1024 + c] : 0.f;
        constexpr int ntile = Ls / 16;
        const _Float16* HD = (const _Float16*)(P.ws + WS_HDN) + (hf ? (size_t)8192 * 64 : 0);
#pragma unroll 8
        for (int tile = wave; tile < ntile; tile += NWAVES) {
            const int t0 = tile * 16;
            const _Float16* ah = HD + (size_t)(t0 + col) * 64 + 8 * kq;
            const f16x8 a0 = *(const f16x8*)ah, a1 = *(const f16x8*)(ah + 32);
            f32x4 d = {0.f, 0.f, 0.f, 0.f};
            d = __builtin_amdgcn_mfma_f32_16x16x32_f16(a0, Bl[0], d, 0, 0, 0);
            d = __builtin_amdgcn_mfma_f32_16x16x32_f16(a1, Bl[1], d, 0, 0, 0);
            d = __builtin_amdgcn_mfma_f32_16x16x32_f16(a0, Bh[0], d, 0, 0, 0);
            d = __builtin_amdgcn_mfma_f32_16x16x32_f16(a1, Bh[1], d, 0, 0, 0);
            if (col < 4) {
#pragma unroll
                for (int rg = 0; rg < 4; ++rg) { const int t = t0 + 4 * kq + rg;
                    float val = d[rg] * (1.0f / 256.0f) * __expf((float)t * tsc);
                    if (t == 0 && !(col & 1)) val += skp;
                    const int idx = (col & 1) ? (N - t) : t;
                    if (!((col & 1) && t == 0)) Df[2 * fft_swz(idx) + (col >> 1)] = val; }
            }
        }
    }
    __syncthreads();
    SEC_END(1);
    SEC_BEGIN(2);
    FFT_MID(LOG2N, 0); FFT_MID(LOG2N, 4); FFT_MID(LOG2N, 8);
    fft_pass_load<RL, LOG2N, 12, true, true>(Dd, tid, v);
    asm volatile("" : "+v"(tid));
#pragma unroll
    for (int up = 0; up < NBF / 2; ++up) { const int bi = 2 * (tid + 512 * up), sq = bi >> (LOG2N - LRL), i0 = bi & (4096 - 1);
        if (sq == 0) {
#pragma unroll
            for (int j = 0; j < RL; ++j) { const FC a = v[(2 * up) * RL + j], b = v[(2 * up + 1) * RL + j]; const f32x4 w = {a.x, a.y, b.x, b.y}; *(f32x4*)(Xs + i0 + (j << 12)) = w; } } }
    __syncthreads();
    SEC_END(2);
    const float* cw = P.conv_w; const float* cb = P.conv_b;
    const float wv0 = cw[c], wv1 = cw[3072 + c], wv2 = cw[6144 + c], bv = cb[c];
    const float wa0 = cw[1024 + c], wa1 = cw[3072 + 1024 + c], wa2 = cw[6144 + 1024 + c], ba = cb[1024 + c];
    const float wb0 = cw[2048 + c], wb1 = cw[3072 + 2048 + c], wb2 = cw[6144 + 2048 + c], bb = cb[2048 + c];
    const bf16* Uv = U + (size_t)c * HTOK; const bf16* Ua = U + (size_t)(1024 + c) * HTOK; const bf16* Ub = U + (size_t)(2048 + c) * HTOK;
    const bf16* Gc = GH + (size_t)c * HTOK; bf16* Hc = HS2 + (size_t)c * HTOK;
    const float invN = 1.0f / (float)N;
    SEC_BEGIN(3);
    asm volatile("" : "+v"(tid));
    {
        FC in[2][8];
        { const int bi = 2 * tid, sq = bi >> (LOG2N - 4), i0 = bi & (nR - 1);
            const bf16* r0 = Uv + (size_t)(2 * sq) * Ls; const bf16* r1 = Uv + (size_t)(2 * sq + 1) * Ls;
#pragma unroll
            for (int k = 0; k < 8; ++k) { const int t = i0 + k * nR;
                const SC2 s0 = sc_load(r0, t, Ls), s1 = sc_load(r1, t, Ls);
                const FC z0 = sc_eval(s0, wv0, wv1, wv2, bv), z1 = sc_eval(s1, wv0, wv1, wv2, bv);
                in[0][k].x = z0.x; in[0][k].y = z1.x; in[1][k].x = z0.y; in[1][k].y = z1.y; } }
        fft_first_from_vals<LOG2N, true>(in, tid, v);
    }
    __syncthreads(); fft_pass_store<16, LOG2N, 0, true>(Dd, tid, v); __syncthreads();
#pragma unroll 1
    for (int ord = 0; ord < 2; ++ord) {
        if (ord == 1) { SEC_BEGIN(4); fft_first_from_lds<LOG2N, true>(Dd, tid, v); __syncthreads(); fft_pass_store<16, LOG2N, 0, true>(Dd, tid, v); __syncthreads(); }
        FFT_MID(LOG2N, 4); FFT_MID(LOG2N, 8);
        asm volatile("" : "+v"(tid));
        fft_pass_load<RL, LOG2N, 12, true, true>(Dd, tid, v);
#pragma unroll
        for (int up = 0; up < NBF / 2; ++up) { const int i0 = (2 * (tid + 512 * up)) & (4096 - 1);
#pragma unroll
            for (int j = 0; j < RL; ++j) { const int f0 = i0 + (j << 12);
                const f32x4 xa = *(const f32x4*)(Xs + f0);
                const FC xb0 = Xs[(N - f0) & (N - 1)], xb1 = Xs[N - f0 - 1];
#pragma unroll
                for (int e = 0; e < 2; ++e) { const FC x1 = {xa[2 * e], xa[2 * e + 1]}; const FC x2 = e ? xb1 : xb0;
                    FC Kf;
                    if (ord == 0) { Kf.x = 0.5f * (x1.x + x2.x); Kf.y = 0.5f * (x1.y - x2.y); }
                    else { Kf.x = 0.5f * (x1.y + x2.y); Kf.y = -0.5f * (x1.x - x2.x); }
                    Kf.x *= invN; Kf.y *= invN;
                    const FC zv = v[(2 * up + e) * RL + j];
                    FC y; y.x = zv.x * Kf.x - zv.y * Kf.y; y.y = -(zv.x * Kf.y + zv.y * Kf.x);
                    v[(2 * up + e) * RL + j] = y; } }
            if ((((up + 1) * RL) & 3) == 0) __builtin_amdgcn_sched_barrier(0); }
        __syncthreads(); fft_pass_store<RL, LOG2N, 12, true>(Dd, tid, v); __syncthreads();
        FFT_MID(LOG2N, 0); FFT_MID(LOG2N, 4); FFT_MID(LOG2N, 8);
        asm volatile("" : "+v"(tid));
        fft_pass_load<RL, LOG2N, 12, true, true>(Dd, tid, v);
        if (ord == 0) {
#pragma unroll
            for (int up = 0; up < NBF / 2; ++up) { const int bi = 2 * (tid + 512 * up), sq = bi >> (LOG2N - LRL), i0 = bi & (4096 - 1);
                const size_t r0 = (size_t)(2 * sq) * Ls, r1 = (size_t)(2 * sq + 1) * Ls;
#pragma unroll
                for (int j = 0; j < NV; ++j) { const int t = i0 + (j << 12);
                    const SC2 sa0 = sc_load(Ua + r0, t, Ls), sa1 = sc_load(Ua + r1, t, Ls);
                    const FC x0 = sc_eval(sa0, wa0, wa1, wa2, ba), x1 = sc_eval(sa1, wa0, wa1, wa2, ba);
                    const FC ya = v[(2 * up) * RL + j], yb = v[(2 * up + 1) * RL + j];
                    FC qa, qb; qa.x = x0.x * ya.x; qa.y = x1.x * (-ya.y); qb.x = x0.y * yb.x; qb.y = x1.y * (-yb.y);
                    v[(2 * up) * RL + j] = qa; v[(2 * up + 1) * RL + j] = qb; }
                if ((((up + 1) * NV) & 3) == 0) __builtin_amdgcn_sched_barrier(0); }
            __syncthreads(); fft_pass_store<RL, LOG2N, 12, true>(Dd, tid, v); __syncthreads();
            SEC_END(3);
        } else {
#pragma unroll
            for (int up = 0; up < NBF / 2; ++up) { const int bi = 2 * (tid + 512 * up), sq = bi >> (LOG2N - LRL), i0 = bi & (4096 - 1);
                const size_t r0 = (size_t)(2 * sq) * Ls, r1 = (size_t)(2 * sq + 1) * Ls;
#pragma unroll
                for (int j = 0; j < NV; ++j) { const int t = i0 + (j << 12);
                    const SC2 sb0 = sc_load(Ub + r0, t, Ls), sb1 = sc_load(Ub + r1, t, Ls);
                    const unsigned g0 = *(const unsigned*)(Gc + r0 + t), g1 = *(const unsigned*)(Gc + r1 + t);
                    const FC x0 = sc_eval(sb0, wb0, wb1, wb2, bb), x1 = sc_eval(sb1, wb0, wb1, wb2, bb);
                    const FC ya = v[(2 * up) * RL + j], yb = v[(2 * up + 1) * RL + j];
                    *(unsigned*)(Hc + r0 + t) = pk2(x0.x * ya.x * bflo(g0), x0.y * yb.x * bfhi(g0));
                    *(unsigned*)(Hc + r1 + t) = pk2(x1.x * (-ya.y) * bflo(g1), x1.y * (-yb.y) * bfhi(g1)); }
                if ((((up + 1) * NV) & 3) == 0) __builtin_amdgcn_sched_barrier(0); }
            __syncthreads();
            SEC_END(4);
        }
    }
}
__device__ __forceinline__ void hyena_unit(const Args& P, LAS unsigned char* lds, int hf, int c, int tid SEC_PARM) {
    if (hf) hyena_unit_t<13>(P, lds, c, tid SEC_ARG); else hyena_unit_t<14>(P, lds, c, tid SEC_ARG);
}

__device__ __forceinline__ void transpose_phase(const Args& P, LAS unsigned char* lds, int hf, int vcu, int G, int tid) {
    const bf16* HS = (const bf16*)((unsigned char*)P.out + (size_t)hf * 64 * MiB + O_HST);
    bf16* HST = (bf16*)(P.ws + WS_R + R_HS);
    LAS bf16* T = (LAS bf16*)lds;
    for (int tile = vcu; tile < 16 * 64; tile += G) {
        const int cb = tile >> 6, tb = tile & 63;
#pragma unroll
        for (int ps = 0; ps < 4; ++ps) { const int rw = (tid >> 5) + 16 * ps, pc = tid & 31;
            const u32x4 v = *(const u32x4*)(HS + (size_t)(cb * 64 + rw) * HTOK + tb * 256 + pc * 8);
            const unsigned w[4] = {v.x, v.y, v.z, v.w};
#pragma unroll
            for (int e = 0; e < 4; ++e) { T[(pc * 8 + 2 * e) * 72 + rw] = (bf16)(w[e] & 0xffffu); T[(pc * 8 + 2 * e + 1) * 72 + rw] = (bf16)(w[e] >> 16); } }
        __syncthreads();
#pragma unroll
        for (int ps = 0; ps < 4; ++ps) { const int it = tid + 512 * ps, tk = it >> 3, ck = it & 7;
            const u32x4 v = *(const LAS u32x4*)(T + tk * 72 + ck * 8);
            *(u32x4*)(HST + (size_t)(tb * 256 + tk) * 1024 + cb * 64 + ck * 8) = v; }
        __syncthreads();
    }
}

__device__ __forceinline__ void norm_phase(const Args& P, int hf, int vcu, int G, int wave, int lane) {
    const bf16* OUT = (const bf16*)(P.ws + WS_R + R_OUT);
    const float* x = hf ? P.xs : P.xp; float* y = P.out + (size_t)hf * HTOK * DM;
    const int gw = vcu * NWAVES + wave, NGW = G * NWAVES;
    f32x4 g4[4];
#pragma unroll
    for (int j = 0; j < 4; ++j) g4[j] = ((const f32x4*)P.post_g)[lane + 64 * j];
    for (int m = gw; m < HTOK; m += NGW) {
        const u32x2* orow = (const u32x2*)(OUT + (size_t)m * DM) + lane;
        f32x4 v[4]; float s = 0.f;
#pragma unroll
        for (int j = 0; j < 4; ++j) { const u32x2 w = orow[64 * j]; v[j] = (f32x4){bflo(w.x), bfhi(w.x), bflo(w.y), bfhi(w.y)}; s += (v[j].x * v[j].x + v[j].y * v[j].y) + (v[j].z * v[j].z + v[j].w * v[j].w); }
        const float rstd = 1.0f / sqrtf(wave_sum(s) * (1.f / DM) + EPS);
        const f32x4* xr = (const f32x4*)(x + (size_t)m * DM) + lane; f32x4* yr = (f32x4*)(y + (size_t)m * DM) + lane;
#pragma unroll
        for (int j = 0; j < 4; ++j) { const f32x4 xv = xr[64 * j]; yr[64 * j] = xv + v[j] * rstd * g4[j]; }
    }
}

__global__ void __launch_bounds__(NTHREADS, 2) mk_fwd(const Args P) {
    extern __shared__ __attribute__((aligned(16))) unsigned char lds_raw[];
    cg::grid_group grid = cg::this_grid();
    LAS unsigned char* lds = (LAS unsigned char*)lds_raw;
    volatile LAS unsigned* MISC = (volatile LAS unsigned*)(lds + MISC_OFF);
    const int tid = threadIdx.x, lane = tid & 63, wave = __builtin_amdgcn_readfirstlane(tid >> 6);
    const int G = gridDim.x, bx = blockIdx.x;
    __builtin_assume(bx >= 0 && bx < 256 && G >= 1 && G <= 256);
    const int vcu = (G % 8 == 0) ? (bx % 8) * (G / 8) + bx / 8 : bx;
    for (int u = tid; u < (LDS_BYTES - RING_BYTES) / 4; u += NTHREADS) ((LAS unsigned*)(lds + RING_BYTES))[u] = 0u;
    __syncthreads();
    XcdBarrier bar = xcd_barrier_post((unsigned*)(P.ws + WS_CTL) + 4096, MISC + 8);
#ifndef NO_P0
    p0_prologue(P, lds, vcu, G, wave, lane);
#ifdef REP_P0
    __syncthreads(); p0_prologue(P, lds, vcu, G, wave, lane);
#endif
#endif
    grid.sync();
    int rep = 0; (void)rep;
    SEC_DECL
#pragma unroll 1
    for (int hf = 0; hf < 2; ++hf) {
#pragma unroll 1
        for (int ph = 1; ph <= 8; ++ph) {
            int tq = threadIdx.x; asm volatile("" : "+v"(tq));
            const int lq = tq & 63, wq = __builtin_amdgcn_readfirstlane(tq >> 6);
            if (ph == 1 || ph == 3 || ph == 6 || ph == 7) {
#ifndef NO_GEMM
                pg8::gemm_phase(lds, P, ph, hf, bx, G);
#endif
            } else if (ph == 2) {
#ifndef NO_ATTN
                for (int g = 0; g < 3; ++g) {
                    for (int u = bx; u < 512; u += G) { attn_unit(P, lds, hf, g, u, tq, wq, lq SEC_ARG3); SEC_SPIN(); }
                    if (g < 2) xcd_barrier(bar);
                }
#endif
            } else if (ph == 4) {
#ifndef NO_HY
                for (int c = bx; c < 1024; c += G) hyena_unit(P, lds, hf, c, tq SEC_ARG);
                SEC_SPIN();
#endif
            } else if (ph == 5) {
                transpose_phase(P, lds, hf, vcu, G, tq);
            } else {
                norm_phase(P, hf, vcu, G, wq, lq);
            }
            if (!(hf == 1 && ph == 8)) xcd_barrier(bar);
#ifdef REP_PH
            if (ph == REP_PH && rep == 0) { rep = 1; --ph; } else rep = 0;
#endif
        }
    }
}

extern "C" void kernel_launch(void* const* d_in, const int* in_sizes, int n_in, void* d_out, int out_size, void* d_ws, size_t ws_size, hipStream_t stream) {
    static int grid = 0;
    if (grid == 0) {
        int dev = 0, cus = 0, per_cu = 0;
        (void)hipGetDevice(&dev);
        (void)hipDeviceGetAttribute(&cus, hipDeviceAttributeMultiprocessorCount, dev);
        (void)hipFuncSetAttribute((const void*)mk_fwd, hipFuncAttributeMaxDynamicSharedMemorySize, LDS_BYTES);
        (void)hipOccupancyMaxActiveBlocksPerMultiprocessor(&per_cu, (const void*)mk_fwd, NTHREADS, LDS_BYTES);
        (void)hipGetLastError();
        grid = cus > 256 ? 256 : cus;
        if (per_cu < 1 || n_in != 20 || ws_size < 256 * MiB) { fprintf(stderr, "kernel_launch: per_cu %d n_in %d ws %zu: unsupported\n", per_cu, n_in, ws_size); grid = -1; }
    }
    if (grid < 0) return;
    (void)hipMemsetAsync(d_ws, 0, 1u << 20, stream);
    Args a{};
    { const float** f = (const float**)&a; for (int i = 0; i < 20; ++i) f[i] = (const float*)d_in[i]; }
    a.out = (float*)d_out; a.ws = (unsigned char*)d_ws;
    void* kargs[] = {&a};
    hipError_t e = hipLaunchCooperativeKernel((const void*)mk_fwd, dim3(grid), dim3(NTHREADS), kargs, LDS_BYTES, stream);
    if (e != hipSuccess) fprintf(stderr, "cooperative launch failed: %s (grid %d)\n", hipGetErrorString(e), grid);
}
```

```cpp
#include <hip/hip_runtime.h>
#include <hip/hip_cooperative_groups.h>
#include <cstdio>
#include <cstdint>
namespace cg = cooperative_groups;

#define GAS __attribute__((address_space(1)))
#define LAS __attribute__((address_space(3)))
typedef unsigned short bf16;
typedef short bf16x8 __attribute__((ext_vector_type(8)));
typedef short s16x4 __attribute__((ext_vector_type(4)));
typedef float f32x4 __attribute__((ext_vector_type(4)));
typedef _Float16 f16x8 __attribute__((ext_vector_type(8)));
typedef unsigned u32x4 __attribute__((ext_vector_type(4)));
typedef unsigned u32x2 __attribute__((ext_vector_type(2)));

constexpr int NWAVES = 8, NTHREADS = 512;
constexpr int LDS_BYTES = 147456;
constexpr int RING_BYTES = 131072;
constexpr int MISC_OFF = RING_BYTES + 320;
constexpr int HY_W4_OFF = RING_BYTES + 2048;
constexpr int DM = 1024, MTOK = 32768, HTOK = 16384;
constexpr float EPS = 1e-6f;
constexpr size_t MiB = (size_t)1 << 20;
constexpr size_t WS_CTL = 0, WS_WT = 1 * MiB, WS_WBA = 23 * MiB, WS_WBH = 24 * MiB, WS_WO = 26 * MiB, WS_HDN = 28 * MiB, WS_BT = 31 * MiB, WS_XN = 32 * MiB, WS_R = 96 * MiB;
constexpr size_t R_QK = 0, R_VT = 96 * MiB, R_GA = 144 * MiB;
constexpr size_t R_U = 0, R_HS = 96 * MiB, R_XS = 128 * MiB;
constexpr size_t R_MGS = 0, R_MRG = 64 * MiB, R_OUT = 96 * MiB;
constexpr size_t O_AS = 0, O_HST = 16 * MiB, O_ZZ = 48 * MiB;

__device__ __forceinline__ unsigned f2bf(float f) { unsigned u = __builtin_bit_cast(unsigned, f); return (u + 0x7fffu + ((u >> 16) & 1u)) >> 16; }
__device__ __forceinline__ unsigned pk2(float lo, float hi) { return f2bf(lo) | (f2bf(hi) << 16); }
__device__ __forceinline__ float bf2f(unsigned h) { return __builtin_bit_cast(float, h << 16); }
__device__ __forceinline__ float bflo(unsigned w) { return __builtin_bit_cast(float, w << 16); }
__device__ __forceinline__ float bfhi(unsigned w) { return __builtin_bit_cast(float, w & 0xffff0000u); }
__device__ __forceinline__ float sigmoidf_(float x) { return __builtin_amdgcn_rcpf(1.0f + __expf(-x)); }
__device__ __forceinline__ float wave_sum(float v) {
#pragma unroll
    for (int o = 1; o < 64; o <<= 1) v += __shfl_xor(v, o);
    return v;
}
#define LDS_WAIT() asm volatile("s_waitcnt lgkmcnt(0)" ::: "memory")
#ifdef PROBE_SEC
#define SEC_DECL unsigned long long sec_acc = 0ull, sec_t0 = 0ull; (void)sec_t0;
#define SEC_BEGIN(id) do { if ((id) == PROBE_SEC) { __syncthreads(); sec_t0 = __builtin_amdgcn_s_memrealtime(); } } while (0)
#define SEC_END(id) do { if ((id) == PROBE_SEC) { __syncthreads(); sec_acc += __builtin_amdgcn_s_memrealtime() - sec_t0; } } while (0)
#define SEC_SPIN() do { const unsigned long long _s = __builtin_amdgcn_s_memrealtime(); while (__builtin_amdgcn_s_memrealtime() - _s < sec_acc * PROBE_AMP) __builtin_amdgcn_s_sleep(8); sec_acc = 0ull; } while (0)
#define SECW_BEGIN(id) do { if ((id) == PROBE_SEC) { sec_t0 = __builtin_amdgcn_s_memrealtime(); } } while (0)
#define SECW_END(id) do { if ((id) == PROBE_SEC) { asm volatile("s_waitcnt vmcnt(0) lgkmcnt(0)" ::: "memory"); sec_acc += __builtin_amdgcn_s_memrealtime() - sec_t0; } } while (0)
#else
#define SECW_BEGIN(id) do {} while (0)
#define SECW_END(id) do {} while (0)
#define SEC_DECL
#define SEC_BEGIN(id) do {} while (0)
#define SEC_END(id) do {} while (0)
#define SEC_SPIN() do {} while (0)
#endif
#ifndef PROBE_AMP
#define PROBE_AMP 1
#endif

#define XB_TMO      128
#define XB_XCNT(j)  (256  + 64 * (j))
#define XB_XSUB(j)  (1280 + 64 * (j))
#define XB_XGEN(j)  (2304 + 64 * (j))
#define XB_TOP      3328
#define XB_TOPGEN   3392
#define XCD_BAR_WORDS 3456
#define XB_SPIN_CAP (1u << 18)
__device__ __forceinline__ unsigned xb_ld(unsigned* p)              { return __hip_atomic_load(p, __ATOMIC_RELAXED, __HIP_MEMORY_SCOPE_AGENT); }
__device__ __forceinline__ unsigned xb_add(unsigned* p, unsigned v) { return __hip_atomic_fetch_add(p, v, __ATOMIC_RELAXED, __HIP_MEMORY_SCOPE_AGENT); }
__device__ __forceinline__ unsigned xb_xcc_id() { return (unsigned)__builtin_amdgcn_s_getreg((3 << 11) | 20) & 0xFu; }
#define XB_SPIN(cond, bar) do { unsigned _sp = 0; while (cond) { __builtin_amdgcn_s_sleep(1); \
    if ((++_sp & 255u) == 0u) { if (xb_ld(&(bar)[XB_TMO])) break; if (_sp > XB_SPIN_CAP) { atomicAdd(&(bar)[XB_TMO], 1u); break; } } } } while (0)
struct XcdBarrier { unsigned* bar; unsigned x; volatile LAS unsigned* st; };
__device__ __forceinline__ XcdBarrier xcd_barrier_post(unsigned* bar, volatile LAS unsigned* st) {
    XcdBarrier b; b.bar = bar; b.x = xb_xcc_id(); b.st = st;
    if (threadIdx.x == 0) (void)xb_add(&bar[XB_XCNT(b.x)], 1u);
    return b;
}
__device__ __forceinline__ void xcd_barrier_complete(unsigned* bar, unsigned x, unsigned& nloc, unsigned& nx) {
    const unsigned G = gridDim.x * gridDim.y * gridDim.z;
    unsigned sum, cnt, mine, sp = 0u;
    for (;;) {
        sum = 0u; cnt = 0u; mine = 0u;
#pragma unroll
        for (unsigned j = 0; j < 16; ++j) { const unsigned c = xb_ld(&bar[XB_XCNT(j)]); sum += c; cnt += (c > 0u) ? 1u : 0u; mine = (j == x) ? c : mine; }
        if (sum == G) break;
        __builtin_amdgcn_s_sleep(1);
        if ((++sp & 255u) == 0u) { if (xb_ld(&bar[XB_TMO])) break; if (sp > XB_SPIN_CAP) { atomicAdd(&bar[XB_TMO], 1u); break; } }
    }
    nloc = mine > 0u ? mine : 1u; nx = cnt > 0u ? cnt : 1u;
}
__device__ __forceinline__ void xcd_barrier(const XcdBarrier& b) {
    asm volatile("s_waitcnt vmcnt(0)" ::: "memory");
    __syncthreads();
    if (threadIdx.x == 0) {
        unsigned* bar = b.bar;
        __builtin_amdgcn_s_waitcnt(0);
        unsigned nloc = b.st[0], nx = b.st[1];
        if (nloc == 0u) { xcd_barrier_complete(bar, b.x, nloc, nx); b.st[0] = nloc; b.st[1] = nx; }
        const unsigned old = xb_add(&bar[XB_XSUB(b.x)], 1u);
        const unsigned gen = old / nloc;
        if (old + 1u == (gen + 1u) * nloc) {
            __builtin_amdgcn_fence(__ATOMIC_RELEASE, "agent");
            asm volatile("s_waitcnt vmcnt(0)" ::: "memory");
            const unsigned og = xb_add(&bar[XB_TOP], 1u);
            const unsigned tg = og / nx;
            if (og + 1u == (tg + 1u) * nx) xb_add(&bar[XB_TOPGEN], 1u);
            else XB_SPIN(xb_ld(&bar[XB_TOPGEN]) == tg, bar);
            __builtin_amdgcn_fence(__ATOMIC_ACQUIRE, "agent");
            xb_add(&bar[XB_XGEN(b.x)], 1u);
            asm volatile("s_waitcnt vmcnt(0)" ::: "memory");
        } else {
            XB_SPIN(xb_ld(&bar[XB_XGEN(b.x)]) == gen, bar);
            __builtin_amdgcn_fence(__ATOMIC_ACQUIRE, "agent");
            asm volatile("s_waitcnt vmcnt(0)" ::: "memory");
        }
    }
    __syncthreads();
}

struct Args {
    const float *xp, *xs, *rel_bias, *pre_g, *post_g, *w_in, *conv_w, *conv_b, *fw1, *fb1, *fw2, *fb2, *fw3, *fb3, *fw4, *ffreq, *skip, *wba, *wbh, *wout;
    float* out; unsigned char* ws;
};

#define FDEV __device__ __forceinline__
#define FLAS __attribute__((address_space(3)))
#define FFT_OPAQUE(x) asm volatile("" : "+v"(x))
typedef float FC __attribute__((ext_vector_type(2)));
__device__ __forceinline__ float fft_cos_turns(float t) { return __builtin_amdgcn_cosf(t); }
__device__ __forceinline__ float fft_sin_turns(float t) { return __builtin_amdgcn_sinf(t); }

FDEV int fft_swz(int idx) { return idx ^ ((idx >> 4) & 15); }
FDEV FC fft_cmul(FC a, FC b) { FC r; r.x = a.x * b.x - a.y * b.y; r.y = a.x * b.y + a.y * b.x; return r; }

FDEV FC fft_mulw16(FC t, int idx) {
    const float C1 = 0.92387953251128674f, S1 = 0.38268343236508977f, H = 0.70710678118654752f;
    FC r;
    if (idx == 0) { r = t; }
    else if (idx == 4) { r.x = t.y; r.y = -t.x; }
    else if (idx == 2) { r.x = (t.x + t.y) * H; r.y = (t.y - t.x) * H; }
    else if (idx == 6) { r.x = (t.y - t.x) * H; r.y = -(t.x + t.y) * H; }
    else {
        float c, s;
        if (idx == 1) { c = C1; s = S1; } else if (idx == 3) { c = S1; s = C1; } else if (idx == 5) { c = -S1; s = C1; } else { c = -C1; s = S1; }
        r.x = t.x * c + t.y * s; r.y = t.y * c - t.x * s;
    }
    return r;
}
template <int R> FDEV void fft_dft(FC (&a)[R]) {
#pragma unroll
    for (int len = R; len >= 2; len >>= 1) {
        const int half = len >> 1;
#pragma unroll
        for (int g0 = 0; g0 < R; g0 += len) {
#pragma unroll
            for (int k = 0; k < half; ++k) {
                const FC u = a[g0 + k], v = a[g0 + k + half];
                FC su, t; su.x = u.x + v.x; su.y = u.y + v.y; t.x = u.x - v.x; t.y = u.y - v.y;
                a[g0 + k] = su; a[g0 + k + half] = fft_mulw16(t, k * (16 / len));
            }
        }
    }
}
template <int R> FDEV int fft_bitrev(int j) { int r = 0;
#pragma unroll
    for (int b = 1, rb = R >> 1; b < R; b <<= 1, rb >>= 1) if (j & b) r |= rb; return r; }

template <bool PM> FDEV int fft_bi(int tid, int u) { return PM ? (2 * (tid + 512 * (u >> 1)) + (u & 1)) : (tid + 512 * u); }
template <int R, int LOG2N, int LOG2S, bool NOTW, bool PM = false> FDEV void fft_pass_load(const FLAS FC* D, int tid, FC (&v)[32]) {
    FFT_OPAQUE(tid);
    constexpr int LR = (R == 16) ? 4 : (R == 8) ? 3 : (R == 4) ? 2 : 1;
    constexpr int n = 1 << LOG2N, nR = n >> LR;
#pragma unroll
    for (int u = 0; u < 32 / R; ++u) {
        const int bi = fft_bi<PM>(tid, u);
        const int sq = bi >> (LOG2N - LR), i = bi & (nR - 1);
        const int pb = fft_swz(sq * n + i);
        FC a[R];
#pragma unroll
        for (int k = 0; k < R; ++k) a[k] = D[pb + k * nR];
        fft_dft<R>(a);
        if (NOTW) {
#pragma unroll
            for (int j = 0; j < R; ++j) v[u * R + j] = a[fft_bitrev<R>(j)];
        } else {
            const int ps = (i >> LOG2S) << LOG2S;
            const float turns = (float)ps * (1.0f / (float)n);
            FC w[R];
            w[1].x = fft_cos_turns(turns); w[1].y = -fft_sin_turns(turns);
            if (R > 2) { w[2] = fft_cmul(w[1], w[1]); w[3] = fft_cmul(w[2], w[1]); }
            if (R > 4) { w[4] = fft_cmul(w[2], w[2]); w[5] = fft_cmul(w[4], w[1]); w[6] = fft_cmul(w[3], w[3]); w[7] = fft_cmul(w[4], w[3]); }
            if (R > 8) { w[8] = fft_cmul(w[4], w[4]);
#pragma unroll
                for (int j = 9; j < 16; ++j) w[j < R ? j : 0] = fft_cmul(w[8 < R ? 8 : 0], w[(j - 8) < R ? (j - 8) : 0]); }
            v[u * R] = a[0];
#pragma unroll
            for (int j = 1; j < R; ++j) v[u * R + j] = fft_cmul(a[fft_bitrev<R>(j)], w[j]);
        }
    }
}
template <int R, int LOG2N, int LOG2S, bool PM = false> FDEV void fft_pass_store(FLAS FC* D, int tid, const FC (&v)[32]) {
    FFT_OPAQUE(tid);
    constexpr int LR = (R == 16) ? 4 : (R == 8) ? 3 : (R == 4) ? 2 : 1;
    constexpr int n = 1 << LOG2N, nR = n >> LR;
#pragma unroll
    for (int u = 0; u < 32 / R; ++u) {
        const int bi = fft_bi<PM>(tid, u);
        const int sq = bi >> (LOG2N - LR), i = bi & (nR - 1);
        const int q = i & ((1 << LOG2S) - 1), p = i >> LOG2S;
        const int base = sq * n + q + ((R * p) << LOG2S);
        if (LOG2S == 0) {
            const int b2 = base | (p & 15);
#pragma unroll
            for (int j = 0; j < R; ++j) D[b2 ^ j] = v[u * R + j];
        } else if (LOG2S == 4) {
#pragma unroll
            for (int j = 0; j < R; ++j) D[(base ^ j) + 16 * j] = v[u * R + j];
        } else {
            const int b2 = fft_swz(base);
#pragma unroll
            for (int j = 0; j < R; ++j) D[b2 + (j << LOG2S)] = v[u * R + j];
        }
    }
}

template <int LOG2N, bool PM = false> FDEV void fft_first_from_vals(const FC (&in)[2][8], int tid, FC (&v)[32]) {
    constexpr int n = 1 << LOG2N, nR = n >> 4;
#pragma unroll
    for (int u = 0; u < 2; ++u) {
        const int bi = fft_bi<PM>(tid, u), i = bi & (nR - 1);
        FC a[16];
#pragma unroll
        for (int k = 0; k < 8; ++k) { a[k] = in[u][k]; a[k + 8].x = 0.f; a[k + 8].y = 0.f; }
        fft_dft<16>(a);
        const float turns = (float)i * (1.0f / (float)n);
        FC w[16];
        w[1].x = fft_cos_turns(turns); w[1].y = -fft_sin_turns(turns);
        w[2] = fft_cmul(w[1], w[1]); w[3] = fft_cmul(w[2], w[1]);
        w[4] = fft_cmul(w[2], w[2]); w[5] = fft_cmul(w[4], w[1]); w[6] = fft_cmul(w[3], w[3]); w[7] = fft_cmul(w[4], w[3]);
        w[8] = fft_cmul(w[4], w[4]);
#pragma unroll
        for (int j = 9; j < 16; ++j) w[j] = fft_cmul(w[8], w[j - 8]);
        v[u * 16] = a[0];
#pragma unroll
        for (int j = 1; j < 16; ++j) v[u * 16 + j] = fft_cmul(a[fft_bitrev<16>(j)], w[j]);
    }
}
template <int LOG2N, bool PM = false> FDEV void fft_first_from_lds(const FLAS FC* D, int tid, FC (&v)[32]) {
    FFT_OPAQUE(tid);
    constexpr int n = 1 << LOG2N, nR = n >> 4;
    FC in[2][8];
#pragma unroll
    for (int u = 0; u < 2; ++u) {
        const int bi = fft_bi<PM>(tid, u), sq = bi >> (LOG2N - 4), i = bi & (nR - 1);
        const int pb = fft_swz(sq * n + i);
#pragma unroll
        for (int k = 0; k < 8; ++k) in[u][k] = D[pb + k * nR];
    }
    fft_first_from_vals<LOG2N, PM>(in, tid, v);
}

namespace pg8 {
constexpr int BM = 256, BK = 64, HALF = 128, HTB = HALF * BK * 2, STAGE_BYTES = 8 * HTB;
__host__ __device__ __forceinline__ int lds_byte(int r, int c) { const int st = (r >> 4) * 2 + (c >> 5), rr = r & 15, cc = c & 31, ob = rr * 64 + cc * 2; return st * 1024 + (ob ^ (((ob >> 9) & 1) << 5)); }
__host__ __device__ __forceinline__ void stage_rc(int b, int& R, int& C) { const int st = b / 1024, sb = b % 1024, swz = sb ^ (((sb >> 9) & 1) << 5); R = (st >> 1) * 16 + swz / 64; C = (st & 1) * 32 + (swz % 64) / 2; }
__host__ __device__ __forceinline__ int perm32(int rho) { const int n = rho >> 4, i = rho & 15; return 8 * (i >> 2) + 4 * n + (i & 3); }

struct GUnit { const char* A; const char* B; unsigned lda, ldb; int nt, mode; bf16* dst; int ldc; const bf16* aux; int ldaux; float scale; };
__device__ __forceinline__ void unit_order(int l, int nwg, int nM, int nN, int& pm, int& pn) {
    const int q = nwg / 8, xcd = l % 8, off = l / 8; const int wgid = xcd * q + off;
    const int nig = 8 * nN, gid = wgid / nig, fm = gid * 8, gsz = (nM - fm) < 8 ? (nM - fm) : 8;
    pm = fm + ((wgid % nig) % gsz); pn = (wgid % nig) / gsz;
}
__device__ __forceinline__ bool gemm_next(const Args& P, int ph, int hf, int i, int c, int G, GUnit& u) {
    unsigned char* ws = P.ws; const char* WT = (const char*)(ws + WS_WT); const char* XN = (const char*)(ws + WS_XN) + (size_t)hf * HTOK * 2048;
    unsigned char* R = ws + WS_R;
    u.aux = nullptr; u.ldaux = 0; u.scale = 1.f; u.mode = 0; u.lda = 2048; u.ldb = 2048; u.nt = 16;
    const int L = i * G + c;
    if (ph == 1) {
        if (L >= 1280) return false;
        if (L < 896) { int pm, pn; unit_order(L, 896, 64, 14, pm, pn);
            u.A = XN + (size_t)pm * 256 * 2048; u.B = WT + (size_t)pn * 256 * 2048;
            if (pn < 12) { u.dst = (bf16*)(R + R_QK) + (size_t)pm * 256 * 3072 + pn * 256; u.ldc = 3072; u.scale = ((pn & 3) < 2) ? 0.125f : 1.f; }
            else { u.dst = (bf16*)(R + R_GA) + (size_t)pm * 256 * 512 + (pn - 12) * 256; u.ldc = 512; u.mode = 1; }
        } else { int l = L - 896; const int g = l / 128; l -= g * 128; int pm, pn; unit_order(l, 128, 2, 64, pm, pn);
            const int r = (g == 0) ? 1 : (g == 1 ? 4 : 16), S = hf ? 4096 : 8192, tps = S / 256, seq = pn / tps, tq = (pn % tps) * 256, lr = S / r, cc = tq / lr, i0 = tq % lr;
            u.A = WT + (size_t)(3584 + g * 512 + pm * 256) * 2048;
            u.B = XN + (size_t)(seq * S + i0 * r + cc) * 2048; u.ldb = 2048u * r;
            u.dst = (bf16*)(R + R_VT) + (size_t)(g * 512 + pm * 256) * HTOK + pn * 256; u.ldc = HTOK; }
        return true;
    }
    if (ph == 3) {
        if (L >= 1024) return false; int pm, pn; unit_order(L, 1024, 16, 64, pm, pn);
        u.A = WT + (size_t)(5120 + pm * 256) * 2048; u.B = XN + (size_t)pn * 256 * 2048; u.ldc = HTOK;
        if (pm < 12) u.dst = (bf16*)(R + R_U) + (size_t)pm * 256 * HTOK + pn * 256;
        else { u.dst = (bf16*)(R + R_HS) + (size_t)(pm - 12) * 256 * HTOK + pn * 256; u.mode = 1; }
        return true;
    }
    if (ph == 6) {
        const int tile = c + (i >> 2) * G, sub = i & 3; if (tile >= 256) return false;
        const int pm = tile >> 2, pn = tile & 3;
        bf16* MGS = (bf16*)(R + R_MGS) + (size_t)pm * 256 * 2048 + pn * 256; bf16* MRG = (bf16*)(R + R_MRG) + (size_t)pm * 256 * 1024 + pn * 256;
        const char* OS = (const char*)P.out + (size_t)hf * 64 * MiB;
        if (sub < 2) { u.A = XN + (size_t)pm * 256 * 2048; u.B = WT + (size_t)(9216 + sub * 1024 + pn * 256) * 2048; u.dst = MGS + sub * 1024; u.ldc = 2048; u.mode = 2; }
        else if (sub == 2) { u.A = OS + O_AS + (size_t)pm * 256 * 1024; u.lda = 1024; u.B = (const char*)(ws + WS_WBA) + (size_t)pn * 256 * 1024; u.ldb = 1024; u.nt = 8;
            u.dst = MRG; u.ldc = 1024; u.aux = MGS; u.ldaux = 2048; u.mode = 3; }
        else { u.A = (const char*)(R + R_HS) + (size_t)pm * 256 * 2048; u.B = (const char*)(ws + WS_WBH) + (size_t)pn * 256 * 2048; u.dst = MRG; u.ldc = 1024; u.aux = MGS + 1024; u.ldaux = 2048; u.mode = 4; }
        return true;
    }
    if (L >= 256) return false;
    { int pm, pn; unit_order(L, 256, 64, 4, pm, pn);
      u.A = (const char*)(R + R_MRG) + (size_t)pm * 256 * 2048; u.B = (const char*)(ws + WS_WO) + (size_t)pn * 256 * 2048;
      u.dst = (bf16*)(R + R_OUT) + (size_t)pm * 256 * 1024 + pn * 256; u.ldc = 1024; }
    return true;
}

__device__ __forceinline__ void gemm_epi(const f32x4 (&acc)[2][2][4][2], const GUnit& u, int wr, int wc, int fr, int fq) {
    const int row0 = wr * 64 + fr, col0 = wc * 32 + 8 * fq;
#pragma unroll
    for (int ai = 0; ai < 2; ++ai)
#pragma unroll
        for (int m = 0; m < 4; ++m) {
            const int row = row0 + ai * HALF + m * 16;
            bf16* rowp = u.dst + (size_t)row * u.ldc + col0;
#pragma unroll
            for (int bj = 0; bj < 2; ++bj) {
                f32x4 v0 = acc[ai][bj][m][0], v1 = acc[ai][bj][m][1];
                float v[8] = {v0[0], v0[1], v0[2], v0[3], v1[0], v1[1], v1[2], v1[3]};
                if (u.mode == 0) {
#pragma unroll
                    for (int e = 0; e < 8; ++e) v[e] *= u.scale;
                } else if (u.mode == 1) {
#pragma unroll
                    for (int e = 0; e < 8; ++e) v[e] = v[e] * sigmoidf_(v[e]);
                } else if (u.mode == 2) {
#pragma unroll
                    for (int e = 0; e < 8; ++e) v[e] = sigmoidf_(v[e]);
                } else {
                    const u32x4 gw = *(const u32x4*)(u.aux + (size_t)row * u.ldaux + col0 + bj * HALF);
                    float g[8] = {bflo(gw.x), bfhi(gw.x), bflo(gw.y), bfhi(gw.y), bflo(gw.z), bfhi(gw.z), bflo(gw.w), bfhi(gw.w)};
                    if (u.mode == 3) {
#pragma unroll
                        for (int e = 0; e < 8; ++e) v[e] = g[e] * v[e];
                    } else {
                        const u32x4 pw = *(const u32x4*)(rowp + bj * HALF);
                        float p[8] = {bflo(pw.x), bfhi(pw.x), bflo(pw.y), bfhi(pw.y), bflo(pw.z), bfhi(pw.z), bflo(pw.w), bfhi(pw.w)};
#pragma unroll
                        for (int e = 0; e < 8; ++e) v[e] = p[e] + g[e] * v[e];
                    }
                }
                u32x4 w; w.x = pk2(v[0], v[1]); w.y = pk2(v[2], v[3]); w.z = pk2(v[4], v[5]); w.w = pk2(v[6], v[7]);
                *(u32x4*)(rowp + bj * HALF) = w;
            }
        }
}

__device__ __forceinline__ void gemm_phase(LAS unsigned char* lds, const Args& P, int ph, int hf, int c, int G) {
    int tid = threadIdx.x; asm volatile("" : "+v"(tid));
    const int wid = __builtin_amdgcn_readfirstlane(tid >> 6), lane = tid & 63, wr = wid >> 2, wc = wid & 3, fr = lane & 15, fq = lane >> 4;
    unsigned RAv, RBv, C2v; { int R_, C_; stage_rc(tid * 16, R_, C_); RAv = (unsigned)R_; RBv = (unsigned)((R_ & ~31) + perm32(R_ & 31)); C2v = (unsigned)(C_ * 2); }
    const unsigned ldsw = (unsigned)wid * 1024u;
    const int aoff = lds_byte(wr * 64 + fr, fq * 8), boff = lds_byte(wc * 32 + fr, fq * 8);
#define PG8_SA(b, h) (((b) * 2 + (h)) * HTB)
#define PG8_SB(b, h) ((4 + (b) * 2 + (h)) * HTB)
#define PG8_STAGE(bufoff, gbase, ld, ISB) do { const unsigned _o = ((ISB) ? RBv : RAv) * (unsigned)(ld) + C2v; const char* _g = (const char*)(gbase); \
        __builtin_amdgcn_global_load_lds((const unsigned*)(_g + (size_t)_o), (LAS unsigned*)(lds + (bufoff) + ldsw), 16, 0, 0); \
        __builtin_amdgcn_global_load_lds((const unsigned*)(_g + (size_t)(64u * (unsigned)(ld)) + (size_t)_o), (LAS unsigned*)(lds + (bufoff) + ldsw + 8192), 16, 0, 0); } while (0)
#define RA 0
#define RB 1
#define PG8_LDA(dst, b, h) do { _Pragma("unroll") for (int m = 0; m < 4; ++m) _Pragma("unroll") for (int k = 0; k < 2; ++k) dst[m][k] = *(const LAS bf16x8*)(lds + PG8_SA(b, h) + aoff + m * 2048 + k * 1024); } while (0)
#define PG8_LDB(dst, b, h) do { _Pragma("unroll") for (int n = 0; n < 2; ++n) _Pragma("unroll") for (int k = 0; k < 2; ++k) dst[n][k] = *(const LAS bf16x8*)(lds + PG8_SB(b, h) + boff + n * 2048 + k * 1024); } while (0)
#define PG8_MMA(ai, bj, At, Bt) do { __builtin_amdgcn_s_setprio(1); _Pragma("unroll") for (int m = 0; m < 4; ++m) _Pragma("unroll") for (int n = 0; n < 2; ++n) _Pragma("unroll") for (int k = 0; k < 2; ++k) \
        acc[ai][bj][m][n] = __builtin_amdgcn_mfma_f32_16x16x32_bf16(Bt[n][k], At[m][k], acc[ai][bj][m][n], 0, 0, 0); __builtin_amdgcn_s_setprio(0); } while (0)
#define PG8_WAIT_V(n) asm volatile("s_waitcnt vmcnt(" #n ")" ::: "memory")
#define PG8_WAIT_L(n) asm volatile("s_waitcnt lgkmcnt(" #n ")" ::: "memory")
#define PG8_BAR __builtin_amdgcn_s_barrier()
#define PG8_SCHED __builtin_amdgcn_sched_barrier(0)
    int ui = 0;
    const char* cA; const char* cB; unsigned clda, cldb; int nt;
    { GUnit u0; if (!gemm_next(P, ph, hf, 0, c, G, u0)) return; cA = u0.A; cB = u0.B; clda = u0.lda; cldb = u0.ldb; nt = u0.nt; }
    f32x4 acc[2][2][4][2];
#pragma unroll
    for (int a = 0; a < 2; ++a)
#pragma unroll
        for (int b = 0; b < 2; ++b)
#pragma unroll
            for (int m = 0; m < 4; ++m)
#pragma unroll
                for (int n = 0; n < 2; ++n) acc[a][b][m][n] = (f32x4){0.f, 0.f, 0.f, 0.f};
    bf16x8 At[4][2], B0[2][2], B1[2][2];
    const size_t kstep = 128;
    {
        const size_t hA = (size_t)HALF * clda, hB = (size_t)HALF * cldb;
        PG8_STAGE(PG8_SB(0, 0), cB, cldb, RB); PG8_STAGE(PG8_SB(0, 1), cB + hB, cldb, RB); PG8_STAGE(PG8_SA(0, 0), cA, clda, RA); PG8_STAGE(PG8_SA(0, 1), cA + hA, clda, RA);
        if (wr == 1) PG8_BAR;
        PG8_WAIT_V(2); PG8_BAR;
        PG8_STAGE(PG8_SB(1, 0), cB + kstep, cldb, RB); PG8_STAGE(PG8_SA(1, 0), cA + kstep, clda, RA); PG8_STAGE(PG8_SB(1, 1), cB + hB + kstep, cldb, RB);
        PG8_WAIT_V(6); PG8_BAR;
    }
    for (;;) {
        bool has_next = false; const char* nA = cA; const char* nB = cB; unsigned nlda = clda, nldb = cldb; int nnt = nt;
        const size_t hA = (size_t)HALF * clda;
        for (int t = 0; t < nt; t += 2) {
            const bool last = (t == nt - 2);
            if (last) { GUnit un; has_next = gemm_next(P, ph, hf, ui + 1, c, G, un); if (has_next) { nA = un.A; nB = un.B; nlda = un.lda; nldb = un.ldb; nnt = un.nt; } }
            const char* a1 = cA + (size_t)(t + 1) * kstep;
            const char* a2 = last ? nA : cA + (size_t)(t + 2) * kstep; const char* b2 = last ? nB : cB + (size_t)(t + 2) * kstep;
            const unsigned lda2 = last ? nlda : clda, ldb2 = last ? nldb : cldb; const size_t hA2 = (size_t)HALF * lda2, hB2 = (size_t)HALF * ldb2;
            const char* a3 = a2 + kstep; const char* b3 = b2 + kstep;
            PG8_LDB(B0, 0, 0); PG8_LDB(B1, 0, 1); PG8_SCHED; PG8_LDA(At, 0, 0); PG8_STAGE(PG8_SA(1, 1), a1 + hA, clda, RA);
            PG8_WAIT_V(8); PG8_WAIT_L(0); PG8_BAR; PG8_MMA(0, 0, At, B0); PG8_MMA(0, 1, At, B1); PG8_BAR; PG8_SCHED;
            PG8_LDA(At, 0, 1); PG8_STAGE(PG8_SB(0, 0), b2, ldb2, RB); PG8_STAGE(PG8_SB(0, 1), b2 + hB2, ldb2, RB); PG8_STAGE(PG8_SA(0, 0), a2, lda2, RA);
            PG8_WAIT_V(8); PG8_WAIT_L(0); PG8_BAR; PG8_MMA(1, 0, At, B0); PG8_MMA(1, 1, At, B1); PG8_BAR; PG8_SCHED;
            PG8_LDB(B0, 1, 0); PG8_LDB(B1, 1, 1); PG8_SCHED; PG8_LDA(At, 1, 0); PG8_STAGE(PG8_SA(0, 1), a2 + hA2, lda2, RA);
            PG8_WAIT_V(8); PG8_WAIT_L(0); PG8_BAR; PG8_MMA(0, 0, At, B0); PG8_MMA(0, 1, At, B1); PG8_BAR; PG8_SCHED;
            PG8_LDA(At, 1, 1); PG8_STAGE(PG8_SB(1, 0), b3, ldb2, RB); PG8_STAGE(PG8_SB(1, 1), b3 + hB2, ldb2, RB); PG8_STAGE(PG8_SA(1, 0), a3, lda2, RA);
            PG8_WAIT_V(8); PG8_WAIT_L(0); PG8_BAR; PG8_MMA(1, 0, At, B0); PG8_MMA(1, 1, At, B1); PG8_BAR; PG8_SCHED;
        }
        if (wr == 0) PG8_BAR;
        { GUnit ue; (void)gemm_next(P, ph, hf, ui, c, G, ue); gemm_epi(acc, ue, wr, wc, fr, fq); }
        if (!has_next) break;
#pragma unroll
        for (int a = 0; a < 2; ++a)
#pragma unroll
            for (int b = 0; b < 2; ++b)
#pragma unroll
                for (int m = 0; m < 4; ++m)
#pragma unroll
                    for (int n = 0; n < 2; ++n) acc[a][b][m][n] = (f32x4){0.f, 0.f, 0.f, 0.f};
        cA = nA; cB = nB; clda = nlda; cldb = nldb; nt = nnt; ++ui;
        if (wr == 1) PG8_BAR;
    }
    PG8_WAIT_V(0);
    PG8_BAR;
#undef PG8_SA
#undef PG8_SB
#undef PG8_STAGE
#undef RA
#undef RB
#undef PG8_LDA
#undef PG8_LDB
#undef PG8_MMA
#undef PG8_WAIT_V
#undef PG8_WAIT_L
#undef PG8_BAR
#undef PG8_SCHED
}
}

__device__ __forceinline__ void p0_transpose_item(const float* W, int ldw, int c0, int ncols, int K, bf16* WT, int row_off, LAS float* scr, int item, int lane) {
    const int nblk = ncols / 32, kb = item / nblk, nb = item % nblk, k0 = 64 * kb, n0 = 32 * nb;
#pragma unroll 8
    for (int i = 0; i < 32; ++i) { const int kk = 2 * i + (lane >> 5); scr[kk * 33 + (lane & 31)] = W[(size_t)(k0 + kk) * ldw + c0 + n0 + (lane & 31)]; }
    LDS_WAIT(); asm volatile("" ::: "memory");
    const int c = lane & 7;
#pragma unroll
    for (int j = 0; j < 4; ++j) { const int n = (lane >> 3) + 8 * j; const LAS float* s = scr + (8 * c) * 33 + n;
        u32x4 o; o.x = pk2(s[0 * 33], s[1 * 33]); o.y = pk2(s[2 * 33], s[3 * 33]); o.z = pk2(s[4 * 33], s[5 * 33]); o.w = pk2(s[6 * 33], s[7 * 33]);
        *(u32x4*)(WT + (size_t)(row_off + n0 + n) * K + k0 + 8 * c) = o; }
    LDS_WAIT(); asm volatile("" ::: "memory");
}
__device__ __forceinline__ float rdlane(float v, int l) { return __builtin_bit_cast(float, __builtin_amdgcn_readlane(__builtin_bit_cast(int, v), l)); }

__device__ __forceinline__ void p0_prologue(const Args& P, LAS unsigned char* lds, int vcu, int G, int wave, int lane) {
    LAS float* scr = (LAS float*)(lds + wave * 16384);
    const int gw = vcu * NWAVES + wave, NGW = G * NWAVES;
    unsigned char* ws = P.ws;
    constexpr int IT_BLK = 16 * 16;
    constexpr int NIT = 22 * IT_BLK + (512 / 64) * (1024 / 32) + 2 * (1024 / 64) * (1024 / 32);
    for (int it = gw; it < NIT; it += NGW) {
        int r = it;
        if (r < 22 * IT_BLK) { const int b = r / IT_BLK; r -= b * IT_BLK;
            const int src = (b == 0) ? 0 : (b == 1) ? 3 : (b == 2) ? 1 : (b == 3) ? 4 : (b == 4) ? 2 : (b == 5) ? 5 : (b == 6) ? 9 : (b == 7) ? 6 : (b == 8) ? 7 : (b == 9) ? 8 : b;
            p0_transpose_item(P.w_in, 11264, src * 512, 512, 1024, (bf16*)(ws + WS_WT), b * 512, scr, r, lane); continue; }
        r -= 22 * IT_BLK;
        if (r < 256) { p0_transpose_item(P.wba, 1024, 0, 1024, 512, (bf16*)(ws + WS_WBA), 0, scr, r, lane); continue; }
        r -= 256;
        if (r < 512) { p0_transpose_item(P.wbh, 1024, 0, 1024, 1024, (bf16*)(ws + WS_WBH), 0, scr, r, lane); continue; }
        r -= 512;
        p0_transpose_item(P.wout, 1024, 0, 1024, 1024, (bf16*)(ws + WS_WO), 0, scr, r, lane);
    }
    {
        f32x4 g4[4];
#pragma unroll
        for (int j = 0; j < 4; ++j) g4[j] = ((const f32x4*)P.pre_g)[lane + 64 * j];
        for (int m = gw; m < MTOK; m += NGW) {
            const float* xrow = (m < HTOK) ? P.xp + (size_t)m * DM : P.xs + (size_t)(m - HTOK) * DM;
            const f32x4* xr = (const f32x4*)xrow + lane;
            f32x4 v[4]; float s = 0.f;
#pragma unroll
            for (int j = 0; j < 4; ++j) { v[j] = xr[64 * j]; s += (v[j].x * v[j].x + v[j].y * v[j].y) + (v[j].z * v[j].z + v[j].w * v[j].w); }
            const float rstd = 1.0f / sqrtf(wave_sum(s) * (1.f / DM) + EPS);
            unsigned long long* o8 = (unsigned long long*)((bf16*)(ws + WS_XN) + (size_t)m * DM) + lane;
#pragma unroll
            for (int j = 0; j < 4; ++j) o8[64 * j] = (unsigned long long)pk2(v[j].x * rstd * g4[j].x, v[j].y * rstd * g4[j].y) | ((unsigned long long)pk2(v[j].z * rstd * g4[j].z, v[j].w * rstd * g4[j].w) << 32);
        }
    }
    {
        const float fr = P.ffreq[lane], b1 = P.fb1[lane], b2 = P.fb2[lane], b3 = P.fb3[lane];
        for (int row = gw; row < 12288; row += NGW) {
            const int Lf = (row < 8192) ? 8192 : 4096, t = (row < 8192) ? row : row - 8192;
            const float tt = (float)t * (1.0f / (float)(Lf - 1));
            const float ang = (6.283185307179586f / (float)Lf) * (float)t;
            const int k = (lane >= 17) ? lane - 17 : lane - 1;
            const float band = 1e-4f + (float)(k & 15) * ((15.0f - 1e-4f) / 15.0f);
            const float a = ang * band;
            float z = (lane == 0) ? tt : ((lane <= 16) ? cosf(a) : -sinf(a));
            float acc = b1;
#pragma unroll
            for (int i = 0; i < 33; ++i) acc += rdlane(z, i) * P.fw1[i * 64 + lane];
            float h = sinf(fr * acc);
            acc = b2;
#pragma unroll 16
            for (int i = 0; i < 64; ++i) acc += rdlane(h, i) * P.fw2[i * 64 + lane];
            h = sinf(fr * acc);
            acc = b3;
#pragma unroll 16
            for (int i = 0; i < 64; ++i) acc += rdlane(h, i) * P.fw3[i * 64 + lane];
            h = sinf(fr * acc);
            ((_Float16*)(ws + WS_HDN))[(size_t)row * 64 + lane] = (_Float16)h;
        }
    }
    {
        float* BT = (float*)(ws + WS_BT);
        for (int e = gw * 64 + lane; e < 3 * 8 * 129; e += NGW * 64) {
            const int g = e / (8 * 129), h = (e / 129) % 8, dd = e % 129;
            const int r = (g == 0) ? 1 : (g == 1 ? 4 : 16);
            const int rel = (dd - 64) * r; const int n = rel < 0 ? -rel : rel;
            const float nf = (float)(n > 1 ? n : 1);
            int large = 8 + (int)(logf(nf / 8.0f) / 4.852030263919617f * 8.0f);
            large = large < 15 ? large : 15;
            const int bucket = (rel > 0 ? 16 : 0) + (n < 8 ? n : large);
            BT[e] = P.rel_bias[bucket * 24 + g * 8 + h];
        }
    }
}

constexpr int AT_KS = 0, AT_VS = 49152, AT_VROW = 776, AT_BT = AT_VS + 64 * AT_VROW;
constexpr size_t WS_LSE = WS_HDN + 2 * MiB - 512 * 1024;
#ifdef PROBE_SEC
#define SEC_PARM3 , unsigned long long& sec_acc
#define SEC_ARG3 , sec_acc
#else
#define SEC_PARM3
#define SEC_ARG3
#endif
__device__ __forceinline__ void attn_unit(const Args& P, LAS unsigned char* lds, int hf, int g, int u, int tid, int wave, int lane SEC_PARM3) {
#ifdef PROBE_SEC
    unsigned long long sec_t0 = 0ull; (void)sec_t0;
#endif
    const int S = hf ? 4096 : 8192, r = (g == 0) ? 1 : (g == 1 ? 4 : 16), lr = S / r, nchunk = lr / 256;
    const int h = u & 7; int rest = u >> 3; const int chunk = rest % nchunk; rest /= nchunk; const int c = rest % r, seq = rest / r;
    const int hs = seq * S, i0 = chunk * 256, kbase = i0 - 64;
    unsigned char* R = P.ws + WS_R;
    const bf16* QK = (const bf16*)(R + R_QK); const bf16* VT = (const bf16*)(R + R_VT); const bf16* GA = (const bf16*)(R + R_GA);
    bf16* OS = (bf16*)((unsigned char*)P.out + (size_t)hf * 64 * MiB + O_AS);
    float* LS = (float*)(P.ws + WS_LSE);
    LAS float* BTL = (LAS float*)(lds + AT_BT);
    SECW_BEGIN(11);
    {
        const bf16* kg = QK + g * 1024 + 512 + h * 64; const bf16* vg = VT + (size_t)(g * 512 + h * 64) * HTOK + hs + c * lr;
        u32x4 kv[6], vv[6];
#pragma unroll
        for (int it = 0; it < 6; ++it) { const int idx = tid + 512 * it;
            { const int kk = idx >> 3, ch = idx & 7, ki = kbase + kk; kv[it] = (u32x4){0u, 0u, 0u, 0u};
              if (ki >= 0 && ki < lr) kv[it] = *(const u32x4*)(kg + (size_t)(hs + ki * r + c) * 3072 + ch * 8); }
            { const int d = idx / 48, kc = idx - d * 48, ki = kbase + 8 * kc; vv[it] = (u32x4){0u, 0u, 0u, 0u};
              if (ki >= 0 && ki < lr) vv[it] = *(const u32x4*)(vg + (size_t)d * HTOK + ki); } }
        if (tid < 129) BTL[tid] = ((const float*)(P.ws + WS_BT))[(g * 8 + h) * 129 + tid];
#pragma unroll
        for (int it = 0; it < 6; ++it) { const int idx = tid + 512 * it;
            { const int kk = idx >> 3, ch = idx & 7; *(LAS u32x4*)(lds + AT_KS + kk * 128 + ((ch ^ (kk & 7)) << 4)) = kv[it]; }
            { const int d = idx / 48, kc = idx - d * 48; const u32x2 lo = {vv[it].x, vv[it].y}, hi = {vv[it].z, vv[it].w};
              *(LAS u32x2*)(lds + AT_VS + d * AT_VROW + kc * 16) = lo; *(LAS u32x2*)(lds + AT_VS + d * AT_VROW + kc * 16 + 8) = hi; } }
    }
    __syncthreads();
    SECW_END(11);
    const int a = lane & 15, gq = lane >> 4;
#pragma unroll 1
    for (int j = wave; j < 16; j += 8) {
        SECW_BEGIN(12);
        const int it0 = i0 + 16 * j;
        const size_t row = (size_t)(hs + (it0 + a) * r + c);
        const bf16* qp = QK + row * 3072 + g * 1024 + h * 64 + 8 * gq;
        const bf16x8 q0 = *(const bf16x8*)qp, q1 = *(const bf16x8*)(qp + 32);
        u32x2 orun[4]; float lrun = 0.f; u32x2 gate[4];
        if (g > 0) { lrun = LS[row * 8 + h];
#pragma unroll
            for (int dt = 0; dt < 4; ++dt) orun[dt] = *(const u32x2*)(OS + row * 512 + h * 64 + 16 * dt + 4 * gq); }
        if (g == 2) {
#pragma unroll
            for (int dt = 0; dt < 4; ++dt) gate[dt] = *(const u32x2*)(GA + row * 512 + h * 64 + 16 * dt + 4 * gq); }
        f32x4 s[9];
#pragma unroll
        for (int kt = 0; kt < 9; ++kt) {
            const int kk = 16 * j + 16 * kt + a;
            const bf16x8 k0 = *(const LAS bf16x8*)(lds + AT_KS + kk * 128 + ((gq ^ (kk & 7)) << 4));
            const bf16x8 k1 = *(const LAS bf16x8*)(lds + AT_KS + kk * 128 + (((gq + 4) ^ (kk & 7)) << 4));
            f32x4 z = {0.f, 0.f, 0.f, 0.f};
            z = __builtin_amdgcn_mfma_f32_16x16x32_bf16(k0, q0, z, 0, 0, 0);
            s[kt] = __builtin_amdgcn_mfma_f32_16x16x32_bf16(k1, q1, z, 0, 0, 0);
        }
        float mx = -1e30f;
        const int db = 4 * gq - a;
#pragma unroll
        for (int kt = 0; kt < 9; ++kt) {
            const int ki0 = it0 - 64 + 16 * kt; const bool tv = (ki0 >= 0) && (ki0 < lr);
#pragma unroll
            for (int rg = 0; rg < 4; ++rg) {
                const int dd = db + 16 * kt + rg;
                bool ok = tv; if (kt == 0) ok = ok && (dd >= 0); if (kt == 8) ok = ok && (dd <= 128);
                const int di = (kt == 0) ? (dd < 0 ? 0 : dd) : ((kt == 8) ? (dd > 128 ? 128 : dd) : dd);
                const float v = ok ? s[kt][rg] + BTL[di] : -1e30f;
                s[kt][rg] = v; mx = fmaxf(mx, v);
            }
        }
        mx = fmaxf(mx, __shfl_xor(mx, 16)); mx = fmaxf(mx, __shfl_xor(mx, 32));
        float ls = 0.f;
#pragma unroll
        for (int kt = 0; kt < 9; ++kt)
#pragma unroll
            for (int rg = 0; rg < 4; ++rg) { const float p = __expf(s[kt][rg] - mx); s[kt][rg] = p; ls += p; }
        ls += __shfl_xor(ls, 16); ls += __shfl_xor(ls, 32);
        SECW_END(12);
        SECW_BEGIN(13);
        f32x4 o[4];
#pragma unroll
        for (int dt = 0; dt < 4; ++dt) o[dt] = (f32x4){0.f, 0.f, 0.f, 0.f};
#pragma unroll
        for (int pp = 0; pp < 5; ++pp) {
            const int kt0 = 2 * pp, kt1 = 2 * pp + 1;
            bf16x8 pf;
            { const unsigned w0 = pk2(s[kt0][0], s[kt0][1]), w1 = pk2(s[kt0][2], s[kt0][3]);
              unsigned w2 = 0u, w3 = 0u; if (kt1 < 9) { w2 = pk2(s[kt1 < 9 ? kt1 : 8][0], s[kt1 < 9 ? kt1 : 8][1]); w3 = pk2(s[kt1 < 9 ? kt1 : 8][2], s[kt1 < 9 ? kt1 : 8][3]); }
              const u32x4 pw = {w0, w1, w2, w3}; pf = __builtin_bit_cast(bf16x8, pw); }
#pragma unroll
            for (int dt = 0; dt < 4; ++dt) {
                const LAS unsigned char* vp = lds + AT_VS + (16 * dt + a) * AT_VROW + (16 * j + 4 * gq) * 2;
                const u32x2 va = *(const LAS u32x2*)(vp + kt0 * 32);
                u32x2 vb = {0u, 0u}; if (kt1 < 9) vb = *(const LAS u32x2*)(vp + (kt1 < 9 ? kt1 : 8) * 32);
                const u32x4 vw = {va.x, va.y, vb.x, vb.y};
                o[dt] = __builtin_amdgcn_mfma_f32_16x16x32_bf16(__builtin_bit_cast(bf16x8, vw), pf, o[dt], 0, 0, 0);
            }
        }
        float inv = 1.0f / ls, lse = mx + __logf(ls), wr_ = 0.f;
        if (g > 0) { const float m = fmaxf(lrun, lse); const float e0 = __expf(lrun - m), e1 = __expf(lse - m); const float it_ = 1.0f / (e0 + e1);
            wr_ = e0 * it_; inv *= e1 * it_; lse = m + __logf(e0 + e1); }
#pragma unroll
        for (int dt = 0; dt < 4; ++dt) {
            float v0 = o[dt][0] * inv, v1 = o[dt][1] * inv, v2 = o[dt][2] * inv, v3 = o[dt][3] * inv;
            if (g > 0) { v0 += wr_ * bflo(orun[dt].x); v1 += wr_ * bfhi(orun[dt].x); v2 += wr_ * bflo(orun[dt].y); v3 += wr_ * bfhi(orun[dt].y); }
            if (g == 2) { v0 *= bflo(gate[dt].x); v1 *= bfhi(gate[dt].x); v2 *= bflo(gate[dt].y); v3 *= bfhi(gate[dt].y); }
            const u32x2 w = {pk2(v0, v1), pk2(v2, v3)};
            *(u32x2*)(OS + row * 512 + h * 64 + 16 * dt + 4 * gq) = w;
        }
        if (g < 2 && gq == 0) LS[row * 8 + h] = lse;
        SECW_END(13);
    }
    __syncthreads();
}

template <int LOG2N> __device__ __forceinline__ void fft16k_t(LAS FC* Dd, int tid) {
    FC v[32];
    fft_pass_load<16, LOG2N, 0, false>(Dd, tid, v); __syncthreads(); fft_pass_store<16, LOG2N, 0>(Dd, tid, v); __syncthreads();
    fft_pass_load<16, LOG2N, 4, false>(Dd, tid, v); __syncthreads(); fft_pass_store<16, LOG2N, 4>(Dd, tid, v); __syncthreads();
    fft_pass_load<16, LOG2N, 8, false>(Dd, tid, v); __syncthreads(); fft_pass_store<16, LOG2N, 8>(Dd, tid, v); __syncthreads();
    constexpr int RL = (LOG2N == 14) ? 4 : 2;
    fft_pass_load<RL, LOG2N, 12, true>(Dd, tid, v); __syncthreads(); fft_pass_store<RL, LOG2N, 12>(Dd, tid, v); __syncthreads();
}
__device__ __forceinline__ void fft16k(LAS FC* Dd, int log2n, int tid) {
    if (log2n == 14) fft16k_t<14>(Dd, tid); else fft16k_t<13>(Dd, tid);
}
__device__ __forceinline__ float sconv(const bf16* row, int t, int Ls, float w0, float w1, float w2, float b) {
    const float um = (t > 0) ? bf2f(row[t - 1]) : 0.f, u0 = bf2f(row[t]), up = (t < Ls - 1) ? bf2f(row[t + 1]) : 0.f;
    return um * w0 + u0 * w1 + up * w2 + b;
}
struct SC2 { unsigned wp, wc, wn; };
__device__ __forceinline__ SC2 sc_load(const bf16* row, int t, int Ls) {
    SC2 s; const unsigned* p = (const unsigned*)(row + t);
    s.wc = p[0]; s.wp = (t >= 2) ? p[-1] : 0u; s.wn = (t + 2 < Ls) ? p[1] : 0u; return s;
}
__device__ __forceinline__ FC sc_eval(const SC2& s, float w0, float w1, float w2, float b) {
    const float um = bfhi(s.wp), u0 = bflo(s.wc), u1 = bfhi(s.wc), u2 = bflo(s.wn);
    FC r; r.x = um * w0 + u0 * w1 + u1 * w2 + b; r.y = u0 * w0 + u1 * w1 + u2 * w2 + b; return r;
}
#ifdef PROBE_SEC
#define SEC_PARM , unsigned long long& sec_acc
#define SEC_ARG , sec_acc
#else
#define SEC_PARM
#define SEC_ARG
#endif
#define FFT_MID(L2N, LS) do { fft_pass_load<16, L2N, LS, false>(Dd, tid, v); __syncthreads(); fft_pass_store<16, L2N, LS>(Dd, tid, v); __syncthreads(); } while (0)
template <int LOG2N> __device__ __forceinline__ void hyena_unit_t(const Args& P, LAS unsigned char* lds, int c, int c2, bool from_scr, int tid SEC_PARM) {
#ifdef PROBE_SEC
    unsigned long long sec_t0 = 0ull; (void)sec_t0;
#endif
    constexpr int hf = (LOG2N == 13) ? 1 : 0, Ls = 1 << (LOG2N - 1), N = 1 << LOG2N, nR = N >> 4, RL = (LOG2N == 14) ? 4 : 2, NBF = 32 / RL, NV = RL / 2, LRL = (RL == 4) ? 2 : 1;
    LAS FC* Dd = (LAS FC*)lds;
    LAS float* Df = (LAS float*)lds;
    unsigned char* R = P.ws + WS_R;
    const bf16* U = (const bf16*)(R + R_U); const bf16* GH = (const bf16*)(R + R_HS); bf16* HS2 = (bf16*)((unsigned char*)P.out + (size_t)hf * 64 * MiB + O_HST);
    FC* Xs = (FC*)(R + R_XS) + (size_t)blockIdx.x * 16384;
    float* FSf = (float*)(hf ? (P.ws + WS_XN) : ((unsigned char*)P.out + 64 * MiB)) + (size_t)blockIdx.x * 32768;
    FC v[32];
    SEC_BEGIN(1);
    asm volatile("" : "+v"(tid));
    if (from_scr) {
        const FC* FS = (const FC*)FSf;
#pragma unroll 8
        for (int e = tid; e < 16384; e += NTHREADS) { FC z = {0.f, 0.f}; if (e < N && e != Ls) z = FS[e]; Dd[fft_swz(e)] = z; }
    } else {
        const int lane = tid & 63, wave = __builtin_amdgcn_readfirstlane(tid >> 6), col = lane & 15, kq = lane >> 4;
        if (tid == 0) { FC z = {0.f, 0.f}; Dd[fft_swz(Ls)] = z; }
        if (hf) for (int e = tid; e < 8192; e += NTHREADS) { FC z = {0.f, 0.f}; Dd[fft_swz(8192 + e)] = z; }
        const int cc = (col < 4) ? c : c2, qf = col & 3; const bool colv = (col < 4) || (col < 8 && c2 >= 0);
        f16x8 Bh[2], Bl[2];
#pragma unroll
        for (int s = 0; s < 2; ++s) {
#pragma unroll
            for (int i8 = 0; i8 < 8; ++i8) { const int j = 32 * s + 8 * kq + i8; const float w = colv ? 256.0f * P.fw4[(size_t)j * 4096 + qf * 1024 + cc] : 0.f;
                const _Float16 h = (_Float16)w; Bh[s][i8] = h; Bl[s][i8] = (_Float16)(w - (float)h); } }
        const float delta = fabsf(-3.0701134573253945f + (float)(colv ? cc : 0) * ((-15.350567286626973f + 3.0701134573253945f) / 1023.0f));
        const float tsc = -delta * (1.0f / (float)(Ls - 1));
        const float skp = colv ? P.skip[(qf >> 1) * 1024 + cc] : 0.f;
        constexpr int ntile = Ls / 16;
        const _Float16* HD = (const _Float16*)(P.ws + WS_HDN) + (hf ? (size_t)8192 * 64 : 0);
#pragma unroll 8
        for (int tile = wave; tile < ntile; tile += NWAVES) {
            const int t0 = tile * 16;
            const _Float16* ah = HD + (size_t)(t0 + col) * 64 + 8 * kq;
            const f16x8 a0 = *(const f16x8*)ah, a1 = *(const f16x8*)(ah + 32);
            f32x4 d = {0.f, 0.f, 0.f, 0.f};
            d = __builtin_amdgcn_mfma_f32_16x16x32_f16(a0, Bl[0], d, 0, 0, 0);
            d = __builtin_amdgcn_mfma_f32_16x16x32_f16(a1, Bl[1], d, 0, 0, 0);
            d = __builtin_amdgcn_mfma_f32_16x16x32_f16(a0, Bh[0], d, 0, 0, 0);
            d = __builtin_amdgcn_mfma_f32_16x16x32_f16(a1, Bh[1], d, 0, 0, 0);
            if (colv) {
#pragma unroll
                for (int rg = 0; rg < 4; ++rg) { const int t = t0 + 4 * kq + rg;
                    float val = d[rg] * (1.0f / 256.0f) * __expf((float)t * tsc);
                    if (t == 0 && !(qf & 1)) val += skp;
                    const int idx = (qf & 1) ? (N - t) : t;
                    if (!((qf & 1) && t == 0)) { if (col < 4) Df[2 * fft_swz(idx) + (qf >> 1)] = val; else FSf[2 * idx + (qf >> 1)] = val; } }
            }
        }
    }
    __syncthreads();
    SEC_END(1);
    SEC_BEGIN(2);
    FFT_MID(LOG2N, 0); FFT_MID(LOG2N, 4); FFT_MID(LOG2N, 8);
    fft_pass_load<RL, LOG2N, 12, true, true>(Dd, tid, v);
    asm volatile("" : "+v"(tid));
#pragma unroll
    for (int up = 0; up < NBF / 2; ++up) { const int bi = 2 * (tid + 512 * up), sq = bi >> (LOG2N - LRL), i0 = bi & (4096 - 1);
        if (sq == 0) {
#pragma unroll
            for (int j = 0; j < RL; ++j) { const FC a = v[(2 * up) * RL + j], b = v[(2 * up + 1) * RL + j]; const f32x4 w = {a.x, a.y, b.x, b.y}; *(f32x4*)(Xs + i0 + (j << 12)) = w; } } }
    __syncthreads();
    SEC_END(2);
    const float* cw = P.conv_w; const float* cb = P.conv_b;
    const float wv0 = cw[c], wv1 = cw[3072 + c], wv2 = cw[6144 + c], bv = cb[c];
    const float wa0 = cw[1024 + c], wa1 = cw[3072 + 1024 + c], wa2 = cw[6144 + 1024 + c], ba = cb[1024 + c];
    const float wb0 = cw[2048 + c], wb1 = cw[3072 + 2048 + c], wb2 = cw[6144 + 2048 + c], bb = cb[2048 + c];
    const bf16* Uv = U + (size_t)c * HTOK; const bf16* Ua = U + (size_t)(1024 + c) * HTOK; const bf16* Ub = U + (size_t)(2048 + c) * HTOK;
    const bf16* Gc = GH + (size_t)c * HTOK; bf16* Hc = HS2 + (size_t)c * HTOK;
    const float invN = 1.0f / (float)N;
    SEC_BEGIN(3);
    asm volatile("" : "+v"(tid));
    {
        FC in[2][8];
        { const int bi = 2 * tid, sq = bi >> (LOG2N - 4), i0 = bi & (nR - 1);
            const bf16* r0 = Uv + (size_t)(2 * sq) * Ls; const bf16* r1 = Uv + (size_t)(2 * sq + 1) * Ls;
#pragma unroll
            for (int k = 0; k < 8; ++k) { const int t = i0 + k * nR;
                const SC2 s0 = sc_load(r0, t, Ls), s1 = sc_load(r1, t, Ls);
                const FC z0 = sc_eval(s0, wv0, wv1, wv2, bv), z1 = sc_eval(s1, wv0, wv1, wv2, bv);
                in[0][k].x = z0.x; in[0][k].y = z1.x; in[1][k].x = z0.y; in[1][k].y = z1.y; } }
        fft_first_from_vals<LOG2N, true>(in, tid, v);
    }
    __syncthreads(); fft_pass_store<16, LOG2N, 0, true>(Dd, tid, v); __syncthreads();
#pragma unroll 1
    for (int ord = 0; ord < 2; ++ord) {
        if (ord == 1) { SEC_BEGIN(4); fft_first_from_lds<LOG2N, true>(Dd, tid, v); __syncthreads(); fft_pass_store<16, LOG2N, 0, true>(Dd, tid, v); __syncthreads(); }
        FFT_MID(LOG2N, 4); FFT_MID(LOG2N, 8);
        asm volatile("" : "+v"(tid));
        fft_pass_load<RL, LOG2N, 12, true, true>(Dd, tid, v);
#pragma unroll
        for (int up = 0; up < NBF / 2; ++up) { const int i0 = (2 * (tid + 512 * up)) & (4096 - 1);
#pragma unroll
            for (int j = 0; j < RL; ++j) { const int f0 = i0 + (j << 12);
                const f32x4 xa = *(const f32x4*)(Xs + f0);
                const FC xb0 = Xs[(N - f0) & (N - 1)], xb1 = Xs[N - f0 - 1];
#pragma unroll
                for (int e = 0; e < 2; ++e) { const FC x1 = {xa[2 * e], xa[2 * e + 1]}; const FC x2 = e ? xb1 : xb0;
                    FC Kf;
                    if (ord == 0) { Kf.x = 0.5f * (x1.x + x2.x); Kf.y = 0.5f * (x1.y - x2.y); }
                    else { Kf.x = 0.5f * (x1.y + x2.y); Kf.y = -0.5f * (x1.x - x2.x); }
                    Kf.x *= invN; Kf.y *= invN;
                    const FC zv = v[(2 * up + e) * RL + j];
                    FC y; y.x = zv.x * Kf.x - zv.y * Kf.y; y.y = -(zv.x * Kf.y + zv.y * Kf.x);
                    v[(2 * up + e) * RL + j] = y; } }
            if ((((up + 1) * RL) & 3) == 0) __builtin_amdgcn_sched_barrier(0); }
        __syncthreads(); fft_pass_store<RL, LOG2N, 12, true>(Dd, tid, v); __syncthreads();
        FFT_MID(LOG2N, 0); FFT_MID(LOG2N, 4); FFT_MID(LOG2N, 8);
        asm volatile("" : "+v"(tid));
        fft_pass_load<RL, LOG2N, 12, true, true>(Dd, tid, v);
        if (ord == 0) {
#pragma unroll
            for (int up = 0; up < NBF / 2; ++up) { const int bi = 2 * (tid + 512 * up), sq = bi >> (LOG2N - LRL), i0 = bi & (4096 - 1);
                const size_t r0 = (size_t)(2 * sq) * Ls, r1 = (size_t)(2 * sq + 1) * Ls;
#pragma unroll
                for (int j = 0; j < NV; ++j) { const int t = i0 + (j << 12);
                    const SC2 sa0 = sc_load(Ua + r0, t, Ls), sa1 = sc_load(Ua + r1, t, Ls);
                    const FC x0 = sc_eval(sa0, wa0, wa1, wa2, ba), x1 = sc_eval(sa1, wa0, wa1, wa2, ba);
                    const FC ya = v[(2 * up) * RL + j], yb = v[(2 * up + 1) * RL + j];
                    FC qa, qb; qa.x = x0.x * ya.x; qa.y = x1.x * (-ya.y); qb.x = x0.y * yb.x; qb.y = x1.y * (-yb.y);
                    v[(2 * up) * RL + j] = qa; v[(2 * up + 1) * RL + j] = qb; }
                if ((((up + 1) * NV) & 3) == 0) __builtin_amdgcn_sched_barrier(0); }
            __syncthreads(); fft_pass_store<RL, LOG2N, 12, true>(Dd, tid, v); __syncthreads();
            SEC_END(3);
        } else {
#pragma unroll
            for (int up = 0; up < NBF / 2; ++up) { const int bi = 2 * (tid + 512 * up), sq = bi >> (LOG2N - LRL), i0 = bi & (4096 - 1);
                const size_t r0 = (size_t)(2 * sq) * Ls, r1 = (size_t)(2 * sq + 1) * Ls;
#pragma unroll
                for (int j = 0; j < NV; ++j) { const int t = i0 + (j << 12);
                    const SC2 sb0 = sc_load(Ub + r0, t, Ls), sb1 = sc_load(Ub + r1, t, Ls);
                    const unsigned g0 = *(const unsigned*)(Gc + r0 + t), g1 = *(const unsigned*)(Gc + r1 + t);
                    const FC x0 = sc_eval(sb0, wb0, wb1, wb2, bb), x1 = sc_eval(sb1, wb0, wb1, wb2, bb);
                    const FC ya = v[(2 * up) * RL + j], yb = v[(2 * up + 1) * RL + j];
                    *(unsigned*)(Hc + r0 + t) = pk2(x0.x * ya.x * bflo(g0), x0.y * yb.x * bfhi(g0));
                    *(unsigned*)(Hc + r1 + t) = pk2(x1.x * (-ya.y) * bflo(g1), x1.y * (-yb.y) * bfhi(g1)); }
                if ((((up + 1) * NV) & 3) == 0) __builtin_amdgcn_sched_barrier(0); }
            __syncthreads();
            SEC_END(4);
        }
    }
}
__device__ __forceinline__ void hyena_unit(const Args& P, LAS unsigned char* lds, int hf, int c, int c2, bool from_scr, int tid SEC_PARM) {
    if (hf) hyena_unit_t<13>(P, lds, c, c2, from_scr, tid SEC_ARG); else hyena_unit_t<14>(P, lds, c, c2, from_scr, tid SEC_ARG);
}

__device__ __forceinline__ void transpose_phase(const Args& P, LAS unsigned char* lds, int hf, int vcu, int G, int tid) {
    const bf16* HS = (const bf16*)((unsigned char*)P.out + (size_t)hf * 64 * MiB + O_HST);
    bf16* HST = (bf16*)(P.ws + WS_R + R_HS);
    LAS bf16* T = (LAS bf16*)lds;
    for (int tile = vcu; tile < 16 * 64; tile += G) {
        const int cb = tile >> 6, tb = tile & 63;
#pragma unroll
        for (int ps = 0; ps < 4; ++ps) { const int rw = (tid >> 5) + 16 * ps, pc = tid & 31;
            const u32x4 v = *(const u32x4*)(HS + (size_t)(cb * 64 + rw) * HTOK + tb * 256 + pc * 8);
            const unsigned w[4] = {v.x, v.y, v.z, v.w};
#pragma unroll
            for (int e = 0; e < 4; ++e) { T[(pc * 8 + 2 * e) * 72 + rw] = (bf16)(w[e] & 0xffffu); T[(pc * 8 + 2 * e + 1) * 72 + rw] = (bf16)(w[e] >> 16); } }
        __syncthreads();
#pragma unroll
        for (int ps = 0; ps < 4; ++ps) { const int it = tid + 512 * ps, tk = it >> 3, ck = it & 7;
            const u32x4 v = *(const LAS u32x4*)(T + tk * 72 + ck * 8);
            *(u32x4*)(HST + (size_t)(tb * 256 + tk) * 1024 + cb * 64 + ck * 8) = v; }
        __syncthreads();
    }
}

__device__ __forceinline__ void norm_phase(const Args& P, int hf, int vcu, int G, int wave, int lane) {
    const bf16* OUT = (const bf16*)(P.ws + WS_R + R_OUT);
    const float* x = hf ? P.xs : P.xp; float* y = P.out + (size_t)hf * HTOK * DM;
    const int gw = vcu * NWAVES + wave, NGW = G * NWAVES;
    f32x4 g4[4];
#pragma unroll
    for (int j = 0; j < 4; ++j) g4[j] = ((const f32x4*)P.post_g)[lane + 64 * j];
    for (int m = gw; m < HTOK; m += NGW) {
        const u32x2* orow = (const u32x2*)(OUT + (size_t)m * DM) + lane;
        f32x4 v[4]; float s = 0.f;
#pragma unroll
        for (int j = 0; j < 4; ++j) { const u32x2 w = orow[64 * j]; v[j] = (f32x4){bflo(w.x), bfhi(w.x), bflo(w.y), bfhi(w.y)}; s += (v[j].x * v[j].x + v[j].y * v[j].y) + (v[j].z * v[j].z + v[j].w * v[j].w); }
        const float rstd = 1.0f / sqrtf(wave_sum(s) * (1.f / DM) + EPS);
        const f32x4* xr = (const f32x4*)(x + (size_t)m * DM) + lane; f32x4* yr = (f32x4*)(y + (size_t)m * DM) + lane;
#pragma unroll
        for (int j = 0; j < 4; ++j) { const f32x4 xv = xr[64 * j]; yr[64 * j] = xv + v[j] * rstd * g4[j]; }
    }
}

__global__ void __launch_bounds__(NTHREADS, 2) mk_fwd(const Args P) {
    extern __shared__ __attribute__((aligned(16))) unsigned char lds_raw[];
    cg::grid_group grid = cg::this_grid();
    LAS unsigned char* lds = (LAS unsigned char*)lds_raw;
    volatile LAS unsigned* MISC = (volatile LAS unsigned*)(lds + MISC_OFF);
    const int tid = threadIdx.x, lane = tid & 63, wave = __builtin_amdgcn_readfirstlane(tid >> 6);
    const int G = gridDim.x, bx = blockIdx.x;
    __builtin_assume(bx >= 0 && bx < 256 && G >= 1 && G <= 256);
    const int vcu = (G % 8 == 0) ? (bx % 8) * (G / 8) + bx / 8 : bx;
    for (int u = tid; u < (LDS_BYTES - RING_BYTES) / 4; u += NTHREADS) ((LAS unsigned*)(lds + RING_BYTES))[u] = 0u;
    __syncthreads();
    XcdBarrier bar = xcd_barrier_post((unsigned*)(P.ws + WS_CTL) + 4096, MISC + 8);
#ifndef NO_P0
    p0_prologue(P, lds, vcu, G, wave, lane);
#ifdef REP_P0
    __syncthreads(); p0_prologue(P, lds, vcu, G, wave, lane);
#endif
#endif
    grid.sync();
    int rep = 0; (void)rep;
    SEC_DECL
#pragma unroll 1
    for (int hf = 0; hf < 2; ++hf) {
#pragma unroll 1
        for (int ph = 1; ph <= 8; ++ph) {
            int tq = threadIdx.x; asm volatile("" : "+v"(tq));
            const int lq = tq & 63, wq = __builtin_amdgcn_readfirstlane(tq >> 6);
            if (ph == 1 || ph == 3 || ph == 6 || ph == 7) {
#ifndef NO_GEMM
                pg8::gemm_phase(lds, P, ph, hf, bx, G);
#endif
            } else if (ph == 2) {
#ifndef NO_ATTN
                for (int g = 0; g < 3; ++g) {
                    for (int u = bx; u < 512; u += G) { attn_unit(P, lds, hf, g, u, tq, wq, lq SEC_ARG3); SEC_SPIN(); }
                    if (g < 2) xcd_barrier(bar);
                }
#endif
            } else if (ph == 4) {
#ifndef NO_HY
                for (int c = bx, k = 0; c < 1024; c += G, ++k) {
                    const bool second = (k & 1); const int c2 = (!second && c + G < 1024) ? c + G : -1;
                    hyena_unit(P, lds, hf, c, c2, second, tq SEC_ARG);
                    SEC_SPIN();
                }
#endif
            } else if (ph == 5) {
                transpose_phase(P, lds, hf, vcu, G, tq);
            } else {
                norm_phase(P, hf, vcu, G, wq, lq);
            }
            if (!(hf == 1 && ph == 8)) xcd_barrier(bar);
#ifdef REP_PH
            if (ph == REP_PH && rep == 0) { rep = 1; --ph; } else rep = 0;
#endif
        }
    }
}

extern "C" void kernel_launch(void* const* d_in, const int* in_sizes, int n_in, void* d_out, int out_size, void* d_ws, size_t ws_size, hipStream_t stream) {
    static int grid = 0;
    if (grid == 0) {
        int dev = 0, cus = 0, per_cu = 0;
        (void)hipGetDevice(&dev);
        (void)hipDeviceGetAttribute(&cus, hipDeviceAttributeMultiprocessorCount, dev);
        (void)hipFuncSetAttribute((const void*)mk_fwd, hipFuncAttributeMaxDynamicSharedMemorySize, LDS_BYTES);
        (void)hipOccupancyMaxActiveBlocksPerMultiprocessor(&per_cu, (const void*)mk_fwd, NTHREADS, LDS_BYTES);
        (void)hipGetLastError();
        grid = cus > 256 ? 256 : cus;
        if (per_cu < 1 || n_in != 20 || ws_size < 256 * MiB) { fprintf(stderr, "kernel_launch: per_cu %d n_in %d ws %zu: unsupported\n", per_cu, n_in, ws_size); grid = -1; }
    }
    if (grid < 0) return;
    (void)hipMemsetAsync(d_ws, 0, 1u << 20, stream);
    Args a{};
    { const float** f = (const float**)&a; for (int i = 0; i < 20; ++i) f[i] = (const float*)d_in[i]; }
    a.out = (float*)d_out; a.ws = (unsigned char*)d_ws;
    void* kargs[] = {&a};
    hipError_t e = hipLaunchCooperativeKernel((const void*)mk_fwd, dim3(grid), dim3(NTHREADS), kargs, LDS_BYTES, stream);
    if (e != hipSuccess) fprintf(stderr, "cooperative launch failed: %s (grid %d)\n", hipGetErrorString(e), grid);
}
```
